# Optimizing an MI355X kernel written in HIP

```python
import jax
import jax.numpy as jnp
from jax import lax
import numpy as np

D_MODEL = 2048
BATCH = 1
SEQ = 8192
DEPTH = 4

N_MIXERS = 3
N_CONV_LAYERS = (DEPTH + 2) // 3
N_MLA_LAYERS = (DEPTH + 1) // 3
N_MLSTM_LAYERS = DEPTH // 3
D_FF = ((8 * D_MODEL + 3 * 256 - 1) // (3 * 256)) * 256
EPS = 1e-6
MOD_SCALE = 0.5
CONV_WIDTH = 3
MLA_HEADS = 16
MLA_Q_LORA = 768
MLA_KV_LORA = 512
MLA_NOPE = 128
MLA_ROPE = 64
MLA_V = 128
ROPE_THETA = 10000.0
ATTN_BLOCK = 128
NEG_INF = -1e30
MLSTM_HEADS = 4
MLSTM_QK = D_MODEL // 2 // MLSTM_HEADS
MLSTM_V = D_MODEL // MLSTM_HEADS
MLSTM_CHUNK = 64
GATE_SOFTCAP = 15.0
FGATE_BIAS = 3.0

kernel_name = 'hybrid_conv_mla_mlstm_adaln_trunk'


def rms_norm(x, g):
    xf = x.astype(jnp.float32)
    y = xf * lax.rsqrt(jnp.mean(xf * xf, axis=-1, keepdims=True) + EPS)
    return (y * g.astype(jnp.float32)).astype(x.dtype)


def apply_rope(x, positions):
    d = x.shape[-1]
    half = d // 2
    inv_freq = jnp.power(ROPE_THETA, -2.0 * jnp.arange(half, dtype=jnp.float32) / d)
    ang = positions.astype(jnp.float32)[..., None] * inv_freq
    cos = jnp.cos(ang)[:, :, None, :]
    sin = jnp.sin(ang)[:, :, None, :]
    xf = x.astype(jnp.float32)
    x1, x2 = xf[..., :half], xf[..., half:]
    return jnp.concatenate([x1 * cos - x2 * sin, x1 * sin + x2 * cos], axis=-1).astype(x.dtype)


def swiglu(h, w_gate, w_up, w_down):
    return (jax.nn.silu(h @ w_gate) * (h @ w_up)) @ w_down


def short_conv_mixer(h, w_in, conv_w, w_out):
    b_gate, c_gate, u = jnp.split(h @ w_in, 3, axis=-1)
    z = lax.conv_general_dilated(
        c_gate * u, conv_w[:, None, :],
        window_strides=(1,), padding=[(CONV_WIDTH - 1, 0)],
        dimension_numbers=('NWC', 'WIO', 'NWC'), feature_group_count=D_MODEL)
    return (b_gate * z) @ w_out


def causal_block_attention(q_nope, q_pe, k_nope, k_pe, v):
    b, s, nh, _ = q_nope.shape
    dv = v.shape[-1]
    nq = s // ATTN_BLOCK
    scale = (MLA_NOPE + MLA_ROPE) ** -0.5
    k_idx = jnp.arange(s)

    def to_blocks(t):
        return jnp.moveaxis(t.reshape(b, nq, ATTN_BLOCK, *t.shape[2:]), 1, 0)

    def block(args):
        qn, qp, start = args
        sc = (jnp.einsum('bqhd,bkhd->bhqk', qn, k_nope)
              + jnp.einsum('bqhd,bkd->bhqk', qp, k_pe)).astype(jnp.float32) * scale
        q_idx = start + jnp.arange(ATTN_BLOCK)
        sc = jnp.where(k_idx[None, :] <= q_idx[:, None], sc, NEG_INF)
        p = jax.nn.softmax(sc, axis=-1).astype(v.dtype)
        return jnp.einsum('bhqk,bkhd->bqhd', p, v)

    starts = jnp.arange(nq) * ATTN_BLOCK
    out = lax.map(block, (to_blocks(q_nope), to_blocks(q_pe), starts))
    return jnp.moveaxis(out, 0, 1).reshape(b, s, nh * dv)


def mla_mixer(h, positions, w_dq, q_norm_g, w_uq, w_dkv, kv_norm_g, w_ukv, w_o):
    b, s, _ = h.shape
    c_q = rms_norm(h @ w_dq, q_norm_g)
    q = (c_q @ w_uq).reshape(b, s, MLA_HEADS, MLA_NOPE + MLA_ROPE)
    q_nope, q_pe = q[..., :MLA_NOPE], apply_rope(q[..., MLA_NOPE:], positions)
    kv_a = h @ w_dkv
    c_kv = rms_norm(kv_a[..., :MLA_KV_LORA], kv_norm_g)
    k_pe = apply_rope(kv_a[..., None, MLA_KV_LORA:], positions)[:, :, 0, :]
    kv = (c_kv @ w_ukv).reshape(b, s, MLA_HEADS, MLA_NOPE + MLA_V)
    k_nope, v = kv[..., :MLA_NOPE], kv[..., MLA_NOPE:]
    return causal_block_attention(q_nope, q_pe, k_nope, k_pe, v) @ w_o


def mlstm_chunkwise(q, k, v, i_pre, log_f):
    b, nh, s, dk = q.shape
    dv = v.shape[-1]
    L = MLSTM_CHUNK
    nc = s // L

    def chunks(t):
        return jnp.moveaxis(t.reshape(b, nh, nc, L, *t.shape[3:]), 2, 0)

    k = k * dk ** -0.5
    f_cum = jnp.cumsum(chunks(log_f), axis=-1)
    tril = jnp.tril(jnp.ones((L, L), dtype=bool))

    def step(carry, inp):
        c_st, n_st, m_st = carry
        qc, kc, vc, ic, fc = inp
        log_d = jnp.where(tril, fc[..., :, None] - fc[..., None, :] + ic[..., None, :], -jnp.inf)
        log_inter = fc + m_st[..., None]
        m_row = jnp.maximum(jnp.max(log_d, axis=-1), log_inter)
        w_intra = jnp.exp(log_d - m_row[..., None])
        w_inter = jnp.exp(log_inter - m_row)
        scores = jnp.einsum('bhjd,bhsd->bhjs', qc, kc) * w_intra
        num = (jnp.einsum('bhjs,bhsv->bhjv', scores, vc)
               + w_inter[..., None] * jnp.einsum('bhjd,bhdv->bhjv', qc, c_st))
        den = jnp.sum(scores, axis=-1) + w_inter * jnp.einsum('bhjd,bhd->bhj', qc, n_st)
        h = num / jnp.maximum(jnp.abs(den), jnp.exp(-m_row))[..., None]
        f_last = fc[..., -1]
        log_w = f_last[..., None] - fc + ic
        m_new = jnp.maximum(f_last + m_st, jnp.max(log_w, axis=-1))
        w_s = jnp.exp(log_w - m_new[..., None])
        decay = jnp.exp(f_last + m_st - m_new)
        c_new = decay[..., None, None] * c_st + jnp.einsum('bhsd,bhsv->bhdv', kc * w_s[..., None], vc)
        n_new = decay[..., None] * n_st + jnp.einsum('bhs,bhsd->bhd', w_s, kc)
        return (c_new, n_new, m_new), h

    init = (jnp.zeros((b, nh, dk, dv), jnp.float32),
            jnp.zeros((b, nh, dk), jnp.float32),
            jnp.zeros((b, nh), jnp.float32))
    _, hs = lax.scan(step, init, (chunks(q), chunks(k), chunks(v), chunks(i_pre), f_cum))
    return jnp.moveaxis(hs, 0, 2).reshape(b, nh, s, dv)


def mlstm_mixer(h, w_in, b_gates, head_norm_g, w_out):
    b, s, _ = h.shape
    nh = MLSTM_HEADS
    qk_w = nh * MLSTM_QK
    v_w = nh * MLSTM_V
    q, k, v, o, gates = jnp.split(
        h @ w_in, [qk_w, 2 * qk_w, 2 * qk_w + v_w, 2 * qk_w + v_w + D_MODEL], axis=-1)

    def heads(t, d):
        return t.reshape(b, s, nh, d).transpose(0, 2, 1, 3).astype(jnp.float32)

    gates = gates.astype(jnp.float32) + b_gates.astype(jnp.float32)
    gates = GATE_SOFTCAP * jnp.tanh(gates / GATE_SOFTCAP)
    i_pre = gates[..., :nh].transpose(0, 2, 1)
    log_f = jax.nn.log_sigmoid(gates[..., nh:]).transpose(0, 2, 1)
    h_t = mlstm_chunkwise(heads(q, MLSTM_QK), heads(k, MLSTM_QK), heads(v, MLSTM_V), i_pre, log_f)
    h_t = rms_norm(h_t.transpose(0, 2, 1, 3), head_norm_g.reshape(nh, MLSTM_V))
    h_t = h_t.reshape(b, s, v_w).astype(h.dtype)
    return (jax.nn.sigmoid(o) * h_t) @ w_out


def setup_inputs(seed: int = 0) -> dict:
    key = jax.random.key(seed)
    keys = iter(jax.random.split(key, 40))

    def normal(shape, scale):
        return scale * jax.random.normal(next(keys), shape, jnp.float32)

    def gain(shape):
        return 1.0 + normal(shape, 0.02)

    x = normal((BATCH, SEQ, D_MODEL), 1.0)
    c = normal((BATCH, D_MODEL), 1.0)
    start = jax.random.randint(next(keys), (BATCH, 1), 0, 1024, dtype=jnp.int32)
    positions = start + jnp.arange(SEQ, dtype=jnp.int32)[None, :]
    mlstm_in_w = 2 * MLSTM_HEADS * MLSTM_QK + MLSTM_HEADS * MLSTM_V + D_MODEL + 2 * MLSTM_HEADS
    mlstm_b_gates = jnp.concatenate(
        [normal((N_MLSTM_LAYERS, MLSTM_HEADS), 0.1),
         FGATE_BIAS + normal((N_MLSTM_LAYERS, MLSTM_HEADS), 0.1)], axis=-1)
    return {
        'x': x,
        'c': c,
        'positions': positions,
        'mod_w': normal((DEPTH, D_MODEL, 6 * D_MODEL), MOD_SCALE * D_MODEL ** -0.5),
        'mod_b': normal((DEPTH, 6 * D_MODEL), 0.02),
        'norm1_g': gain((DEPTH, D_MODEL)),
        'norm2_g': gain((DEPTH, D_MODEL)),
        'ffn_w_gate': normal((DEPTH, D_MODEL, D_FF), D_MODEL ** -0.5),
        'ffn_w_up': normal((DEPTH, D_MODEL, D_FF), D_MODEL ** -0.5),
        'ffn_w_down': normal((DEPTH, D_FF, D_MODEL), D_FF ** -0.5),
        'conv_w_in': normal((N_CONV_LAYERS, D_MODEL, 3 * D_MODEL), D_MODEL ** -0.5),
        'conv_w': normal((N_CONV_LAYERS, CONV_WIDTH, D_MODEL), CONV_WIDTH ** -0.5),
        'conv_w_out': normal((N_CONV_LAYERS, D_MODEL, D_MODEL), D_MODEL ** -0.5),
        'mla_w_dq': normal((N_MLA_LAYERS, D_MODEL, MLA_Q_LORA), D_MODEL ** -0.5),
        'mla_q_norm_g': gain((N_MLA_LAYERS, MLA_Q_LORA)),
        'mla_w_uq': normal((N_MLA_LAYERS, MLA_Q_LORA, MLA_HEADS * (MLA_NOPE + MLA_ROPE)), MLA_Q_LORA ** -0.5),
        'mla_w_dkv': normal((N_MLA_LAYERS, D_MODEL, MLA_KV_LORA + MLA_ROPE), D_MODEL ** -0.5),
        'mla_kv_norm_g': gain((N_MLA_LAYERS, MLA_KV_LORA)),
        'mla_w_ukv': normal((N_MLA_LAYERS, MLA_KV_LORA, MLA_HEADS * (MLA_NOPE + MLA_V)), MLA_KV_LORA ** -0.5),
        'mla_w_o': normal((N_MLA_LAYERS, MLA_HEADS * MLA_V, D_MODEL), (MLA_HEADS * MLA_V) ** -0.5),
        'mlstm_w_in': normal((N_MLSTM_LAYERS, D_MODEL, mlstm_in_w), D_MODEL ** -0.5),
        'mlstm_b_gates': mlstm_b_gates,
        'mlstm_head_norm_g': gain((N_MLSTM_LAYERS, MLSTM_HEADS * MLSTM_V)),
        'mlstm_w_out': normal((N_MLSTM_LAYERS, D_MODEL, D_MODEL), D_MODEL ** -0.5),
        'final_norm_g': gain((D_MODEL,)),
    }


def reference(x, c, positions, mod_w, mod_b, norm1_g, norm2_g, ffn_w_gate, ffn_w_up, ffn_w_down,
              conv_w_in, conv_w, conv_w_out,
              mla_w_dq, mla_q_norm_g, mla_w_uq, mla_w_dkv, mla_kv_norm_g, mla_w_ukv, mla_w_o,
              mlstm_w_in, mlstm_b_gates, mlstm_head_norm_g, mlstm_w_out, final_norm_g):
    c_act = jax.nn.silu(c)
    for i in range(DEPTH):
        mod = (c_act @ mod_w[i] + mod_b[i])[:, None, :]
        sh1, sc1, g1, sh2, sc2, g2 = jnp.split(mod, 6, axis=-1)
        h = rms_norm(x, norm1_g[i]) * (1.0 + sc1) + sh1
        kind, j = i % N_MIXERS, i // N_MIXERS
        if kind == 0:
            y = short_conv_mixer(h, conv_w_in[j], conv_w[j], conv_w_out[j])
        elif kind == 1:
            y = mla_mixer(h, positions, mla_w_dq[j], mla_q_norm_g[j], mla_w_uq[j],
                          mla_w_dkv[j], mla_kv_norm_g[j], mla_w_ukv[j], mla_w_o[j])
        else:
            y = mlstm_mixer(h, mlstm_w_in[j], mlstm_b_gates[j], mlstm_head_norm_g[j], mlstm_w_out[j])
        x = x + g1 * y
        h = rms_norm(x, norm2_g[i]) * (1.0 + sc2) + sh2
        x = x + g2 * swiglu(h, ffn_w_gate[i], ffn_w_up[i], ffn_w_down[i])
    return rms_norm(x, final_norm_g)
```

```cpp
#include <hip/hip_runtime.h>
#include <hip/hip_bf16.h>
#include <cstdio>
#include <cstdint>
#include <cmath>
namespace pg8 {
#define PG8_LAS __attribute__((address_space(3)))
typedef unsigned short bf16_t;
typedef short bf16x8 __attribute__((ext_vector_type(8)));
typedef float f32x4 __attribute__((ext_vector_type(4)));
typedef unsigned u32x4 __attribute__((ext_vector_type(4)));
constexpr int BM = 256, BK = 64, HALF = 128, HTB = HALF * BK * 2  , STAGE_BYTES = 8 * HTB, NXCD = 8, WGM = 8;

__host__ __device__ __forceinline__ int lds_byte(int r, int c) { const int st = (r >> 4) * 2 + (c >> 5), rr = r & 15, cc = c & 31, ob = rr * 64 + cc * 2; return st * 1024 + (ob ^ (((ob >> 9) & 1) << 5)); }
__host__ __device__ __forceinline__ void stage_rc(int b, int& R, int& C) { const int st = b / 1024, sb = b % 1024, swz = sb ^ (((sb >> 9) & 1) << 5); R = (st >> 1) * 16 + swz / 64; C = (st & 1) * 32 + (swz % 64) / 2; }
__host__ __device__ __forceinline__ int perm32(int rho) { const int n = rho >> 4, i = rho & 15; return 8 * (i >> 2) + 4 * n + (i & 3); }

struct Unit { int pm, pn; };
struct Gemm { const bf16_t* A; const bf16_t* Bt; int M, N, K; };

struct StaticOrder {
    int nM, nN, nwg, G, c;
    __host__ __device__ void init(int M, int N, int G_, int c_) { nM = M / BM; nN = N / BM; nwg = nM * nN; G = G_; c = c_; }
    __host__ __device__ bool next(int i, Unit& u) const {
        const long L = (long)i * G + c; if (L >= nwg) return false;
        int wgid = (int)L; { const int q = nwg / NXCD, r = nwg % NXCD, xcd = wgid % NXCD, off = wgid / NXCD; wgid = (xcd < r ? xcd * (q + 1) : r * (q + 1) + (xcd - r) * q) + off; }
        const int nig = WGM * nN, gid = wgid / nig, fm = gid * WGM, gsz = (nM - fm) < WGM ? (nM - fm) : WGM;
        u.pm = fm + ((wgid % nig) % gsz); u.pn = (wgid % nig) / gsz; return true;
    }
    __device__ __forceinline__ void a_ready(const Unit&) const {}
    __device__ __forceinline__ void done(const Unit&) const {}
};

typedef float f32x2 __attribute__((ext_vector_type(2)));
typedef __bf16 bf16x2_t __attribute__((ext_vector_type(2)));
typedef unsigned u32x2 __attribute__((ext_vector_type(2)));
__device__ __forceinline__ unsigned pk2(float lo, float hi) { f32x2 v = {lo, hi}; bf16x2_t r = __builtin_convertvector(v, bf16x2_t); return __builtin_bit_cast(unsigned, r); }
__device__ __forceinline__ u32x4 pk8(const f32x4& a, const f32x4& b) { u32x4 w; w.x = pk2(a[0], a[1]); w.y = pk2(a[2], a[3]); w.z = pk2(b[0], b[1]); w.w = pk2(b[2], b[3]); return w; }
__device__ __forceinline__ float fsigmoid(float v) { return __builtin_amdgcn_rcpf(1.0f + __builtin_amdgcn_exp2f(-1.44269504089f * v)); }
__device__ __forceinline__ float fsilu(float v) { return v * fsigmoid(v); }

struct EpiResid {
    static constexpr bool PERM = false, AFTER_DRAIN = false;
    const float* base; float* out; const float* gate; int ldc;
    __device__ __forceinline__ void operator()(const f32x4 (&acc)[2][2][4][2], const Unit& u, int wr, int wc, int fr, int fq) const {
        const int row0 = u.pm * BM + wr * 64 + fr, col0 = u.pn * BM + wc * 32 + 4 * fq;
        f32x4 gv[2][2];
#pragma unroll
        for (int bj = 0; bj < 2; ++bj)
#pragma unroll
            for (int n = 0; n < 2; ++n) gv[bj][n] = *(const f32x4*)(gate + col0 + bj * HALF + n * 16);
#pragma unroll
        for (int ai = 0; ai < 2; ++ai)
#pragma unroll
            for (int m = 0; m < 4; ++m) { const size_t off = (size_t)(row0 + ai * HALF + m * 16) * ldc + col0;
#pragma unroll
                for (int bj = 0; bj < 2; ++bj)
#pragma unroll
                    for (int n = 0; n < 2; ++n) { const f32x4 b = *(const f32x4*)(base + off + bj * HALF + n * 16); *(f32x4*)(out + off + bj * HALF + n * 16) = b + gv[bj][n] * acc[ai][bj][m][n]; } }
    }
};
struct EpiF32 {
    static constexpr bool PERM = false, AFTER_DRAIN = false;
    float* C; int ldc;
    __device__ __forceinline__ void operator()(const f32x4 (&acc)[2][2][4][2], const Unit& u, int wr, int wc, int fr, int fq) const {
        const int row0 = u.pm * BM + wr * 64 + fr, col0 = u.pn * BM + wc * 32 + 4 * fq;
#pragma unroll
        for (int ai = 0; ai < 2; ++ai)
#pragma unroll
            for (int m = 0; m < 4; ++m) { float* rowp = C + (size_t)(row0 + ai * HALF + m * 16) * ldc + col0;
#pragma unroll
                for (int bj = 0; bj < 2; ++bj)
#pragma unroll
                    for (int n = 0; n < 2; ++n) *(f32x4*)(rowp + bj * HALF + n * 16) = acc[ai][bj][m][n]; }
    }
};
struct EpiSwiGLU {
    static constexpr bool PERM = true, AFTER_DRAIN = false;
    bf16_t* O; int ldc;
    __device__ __forceinline__ void operator()(const f32x4 (&acc)[2][2][4][2], const Unit& u, int wr, int wc, int fr, int fq) const {
        const int row0 = u.pm * BM + wr * 64 + fr, col0 = u.pn * HALF + wc * 32 + 8 * fq;
#pragma unroll
        for (int ai = 0; ai < 2; ++ai)
#pragma unroll
            for (int m = 0; m < 4; ++m) { bf16_t* rowp = O + (size_t)(row0 + ai * HALF + m * 16) * ldc + col0;
                f32x4 v0, v1;
#pragma unroll
                for (int j = 0; j < 4; ++j) { v0[j] = fsilu(acc[ai][0][m][0][j]) * acc[ai][1][m][0][j]; v1[j] = fsilu(acc[ai][0][m][1][j]) * acc[ai][1][m][1][j]; }
                *(u32x4*)rowp = pk8(v0, v1); }
    }
};
struct EpiConvIn {
    static constexpr bool PERM = true, AFTER_DRAIN = false;
    bf16_t* BG; bf16_t* CU; int ldc;
    __device__ __forceinline__ void operator()(const f32x4 (&acc)[2][2][4][2], const Unit& u, int wr, int wc, int fr, int fq) const {
        const int row0 = u.pm * BM + wr * 64 + fr;
        if (u.pn < 8) {
            const int col0 = u.pn * BM + wc * 32 + 8 * fq;
#pragma unroll
            for (int ai = 0; ai < 2; ++ai)
#pragma unroll
                for (int m = 0; m < 4; ++m) { bf16_t* rowp = BG + (size_t)(row0 + ai * HALF + m * 16) * ldc + col0;
#pragma unroll
                    for (int bj = 0; bj < 2; ++bj) *(u32x4*)(rowp + bj * HALF) = pk8(acc[ai][bj][m][0], acc[ai][bj][m][1]); }
        } else {
            const int col0 = (u.pn - 8) * HALF + wc * 32 + 8 * fq;
#pragma unroll
            for (int ai = 0; ai < 2; ++ai)
#pragma unroll
                for (int m = 0; m < 4; ++m) { bf16_t* rowp = CU + (size_t)(row0 + ai * HALF + m * 16) * ldc + col0;
                    *(u32x4*)rowp = pk8(acc[ai][0][m][0] * acc[ai][1][m][0], acc[ai][0][m][1] * acc[ai][1][m][1]); }
        }
    }
};
struct EpiMlstmIn {
    static constexpr bool PERM = true, AFTER_DRAIN = false;
    bf16_t* Q; bf16_t* K; bf16_t* V; bf16_t* OG; float kscale;
    __device__ __forceinline__ void operator()(const f32x4 (&acc)[2][2][4][2], const Unit& u, int wr, int wc, int fr, int fq) const {
        const int row0 = u.pm * BM + wr * 64 + fr; bf16_t* base; int ldc, colt; float sc = 1.f; bool sig = false;
        if (u.pn < 4) { base = Q; ldc = 1024; colt = u.pn * BM; }
        else if (u.pn < 8) { base = K; ldc = 1024; colt = (u.pn - 4) * BM; sc = kscale; }
        else if (u.pn < 16) { base = V; ldc = 2048; colt = (u.pn - 8) * BM; }
        else { base = OG; ldc = 2048; colt = (u.pn - 16) * BM; sig = true; }
        const int col0 = colt + wc * 32 + 8 * fq;
#pragma unroll
        for (int ai = 0; ai < 2; ++ai)
#pragma unroll
            for (int m = 0; m < 4; ++m) { bf16_t* rowp = base + (size_t)(row0 + ai * HALF + m * 16) * ldc + col0;
#pragma unroll
                for (int bj = 0; bj < 2; ++bj) { f32x4 v0 = acc[ai][bj][m][0] * sc, v1 = acc[ai][bj][m][1] * sc;
                    if (sig) {
#pragma unroll
                        for (int j = 0; j < 4; ++j) { v0[j] = fsigmoid(v0[j]); v1[j] = fsigmoid(v1[j]); } }
                    *(u32x4*)(rowp + bj * HALF) = pk8(v0, v1); } }
    }
};
struct EpiQRope {
    static constexpr bool PERM = true, AFTER_DRAIN = false;
    bf16_t* Q; int ldc; float qscale; const float* cs; const float* sn;
    __device__ __forceinline__ void operator()(const f32x4 (&acc)[2][2][4][2], const Unit& u, int wr, int wc, int fr, int fq) const {
        const int row0 = u.pm * BM + wr * 64 + fr, col0 = u.pn * BM + wc * 32 + 8 * fq;
#pragma unroll
        for (int bj = 0; bj < 2; ++bj) {
            const int gi = u.pn * 8 + bj * 4 + wc, g6 = gi % 6;
            if (g6 < 4) {
#pragma unroll
                for (int ai = 0; ai < 2; ++ai)
#pragma unroll
                    for (int m = 0; m < 4; ++m) { bf16_t* rowp = Q + (size_t)(row0 + ai * HALF + m * 16) * ldc + col0 + bj * HALF;
                        *(u32x4*)rowp = pk8(acc[ai][bj][m][0] * qscale, acc[ai][bj][m][1] * qscale); }
            } else {
                const int i0 = 16 * (g6 - 4) + 4 * fq;
#pragma unroll
                for (int ai = 0; ai < 2; ++ai)
#pragma unroll
                    for (int m = 0; m < 4; ++m) { const int row = row0 + ai * HALF + m * 16; bf16_t* rowp = Q + (size_t)row * ldc + col0 + bj * HALF;
                        const f32x4 c = *(const f32x4*)(cs + (size_t)row * 32 + i0), s = *(const f32x4*)(sn + (size_t)row * 32 + i0);
                        const f32x4 x1 = acc[ai][bj][m][0] * qscale, x2 = acc[ai][bj][m][1] * qscale;
                        *(u32x4*)rowp = pk8(x1 * c - x2 * s, x1 * s + x2 * c); }
            }
        }
    }
};
struct EpiKnope {
    static constexpr bool PERM = true, AFTER_DRAIN = false;
    bf16_t* Kc; int ldc;
    __device__ __forceinline__ void operator()(const f32x4 (&acc)[2][2][4][2], const Unit& u, int wr, int wc, int fr, int fq) const {
        const int row0 = u.pm * BM + wr * 64 + fr;
#pragma unroll
        for (int ai = 0; ai < 2; ++ai)
#pragma unroll
            for (int m = 0; m < 4; ++m) { bf16_t* rowp = Kc + (size_t)(row0 + ai * HALF + m * 16) * ldc + wc * 32 + 8 * fq;
#pragma unroll
                for (int bj = 0; bj < 2; ++bj) *(u32x4*)(rowp + (2 * u.pn + bj) * 192) = pk8(acc[ai][bj][m][0], acc[ai][bj][m][1]); }
    }
};
struct EpiVt {
    static constexpr bool PERM = false, AFTER_DRAIN = false;
    bf16_t* Vt; int ldc;
    __device__ __forceinline__ void operator()(const f32x4 (&acc)[2][2][4][2], const Unit& u, int wr, int wc, int fr, int fq) const {
        const int row0 = u.pm * BM + wr * 64 + fr, fqs = ((fq & 1) << 1) | (fq >> 1), col0 = u.pn * BM + wc * 32 + 4 * fqs;
#pragma unroll
        for (int ai = 0; ai < 2; ++ai)
#pragma unroll
            for (int m = 0; m < 4; ++m) { bf16_t* rowp = Vt + (size_t)(row0 + ai * HALF + m * 16) * ldc + col0;
#pragma unroll
                for (int bj = 0; bj < 2; ++bj)
#pragma unroll
                    for (int n = 0; n < 2; ++n) { const f32x4 v = acc[ai][bj][m][n]; u32x2 w; w.x = pk2(v[0], v[1]); w.y = pk2(v[2], v[3]); *(u32x2*)(rowp + bj * HALF + n * 16) = w; } }
    }
};

template <class Epi, class Sched, bool ALIGN_EPI = false, bool SP2 = false>
__device__ __forceinline__ void gemm_phase(PG8_LAS unsigned char* lds, const Gemm g, const Sched& S, const Epi& E) {
    const int tid = threadIdx.x, wid = __builtin_amdgcn_readfirstlane(tid >> 6), lane = tid & 63, wr = wid >> 2, wc = wid & 3, fr = lane & 15, fq = lane >> 4;
    const int K = g.K, nt = K / BK;
    unsigned voffA[2], voffB[2];
#pragma unroll
    for (int i = 0; i < 2; ++i) { int R, C; stage_rc(tid * 16 + i * 8192, R, C); const int Rb = Epi::PERM ? ((R & ~31) + perm32(R & 31)) : R;
        voffA[i] = (unsigned)(R * K + C) * 2u; voffB[i] = (unsigned)(Rb * K + C) * 2u; }
    const size_t kstep = (size_t)(BK * 2);
    const size_t hstep = (size_t)HALF * K * 2;
    const size_t tstep = 2 * hstep;
    const unsigned ldsw = (unsigned)wid * 1024u;
    const int aoff = lds_byte(wr * 64 + fr, fq * 8), boff = lds_byte(wc * 32 + fr, fq * 8);
#define PG8_SA(b, h) (((b) * 2 + (h)) * HTB)
#define PG8_SB(b, h) ((4 + (b) * 2 + (h)) * HTB)
#define PG8_STAGE(bufoff, gbase, voff) do { _Pragma("unroll") for (int _i = 0; _i < 2; ++_i) \
        __builtin_amdgcn_global_load_lds((const unsigned*)((const char*)(gbase) + (voff)[_i]), (PG8_LAS unsigned*)(lds + (bufoff) + ldsw + _i * 8192), 16, 0, 0); } while (0)
#define PG8_LDA(dst, b, h) do { _Pragma("unroll") for (int m = 0; m < 4; ++m) _Pragma("unroll") for (int k = 0; k < 2; ++k) dst[m][k] = *(const PG8_LAS bf16x8*)(lds + PG8_SA(b, h) + aoff + m * 2048 + k * 1024); } while (0)
#define PG8_LDB(dst, b, h) do { _Pragma("unroll") for (int n = 0; n < 2; ++n) _Pragma("unroll") for (int k = 0; k < 2; ++k) dst[n][k] = *(const PG8_LAS bf16x8*)(lds + PG8_SB(b, h) + boff + n * 2048 + k * 1024); } while (0)
#define PG8_MMA(ai, bj, At, Bt) do { __builtin_amdgcn_s_setprio(1); _Pragma("unroll") for (int m = 0; m < 4; ++m) _Pragma("unroll") for (int n = 0; n < 2; ++n) _Pragma("unroll") for (int k = 0; k < 2; ++k) \
        acc[ai][bj][m][n] = __builtin_amdgcn_mfma_f32_16x16x32_bf16(Bt[n][k], At[m][k], acc[ai][bj][m][n], 0, 0, 0); __builtin_amdgcn_s_setprio(0); } while (0)
#define PG8_WAIT_V(n) asm volatile("s_waitcnt vmcnt(" #n ")" ::: "memory")
#define PG8_WAIT_L(n) asm volatile("s_waitcnt lgkmcnt(" #n ")" ::: "memory")
#define PG8_BAR __builtin_amdgcn_s_barrier()
#define PG8_SCHED __builtin_amdgcn_sched_barrier(0)
    Unit cur, nxt; int ui = 0;
    if (!S.next(0, cur)) return;
    f32x4 acc[2][2][4][2];
#pragma unroll
    for (int a = 0; a < 2; ++a)
#pragma unroll
        for (int b = 0; b < 2; ++b)
#pragma unroll
            for (int m = 0; m < 4; ++m)
#pragma unroll
                for (int n = 0; n < 2; ++n) acc[a][b][m][n] = (f32x4){0.f, 0.f, 0.f, 0.f};
    bf16x8 At[4][2], B0[2][2], B1[2][2];
    const char* cA = (const char*)g.A + (size_t)cur.pm * tstep; const char* cB = (const char*)g.Bt + (size_t)cur.pn * tstep;
    S.a_ready(cur);
    if constexpr (SP2) {
        PG8_STAGE(PG8_SB(0, 0), cB, voffB); PG8_STAGE(PG8_SB(0, 1), cB + hstep, voffB); PG8_STAGE(PG8_SA(0, 0), cA, voffA); PG8_STAGE(PG8_SA(0, 1), cA + hstep, voffA);
        if (wr == 1) PG8_BAR;
        PG8_WAIT_V(2); PG8_BAR;
        PG8_STAGE(PG8_SB(1, 0), cB + kstep, voffB); PG8_STAGE(PG8_SA(1, 0), cA + kstep, voffA); PG8_STAGE(PG8_SB(1, 1), cB + hstep + kstep, voffB);
        PG8_WAIT_V(6); PG8_BAR;
    } else {
        PG8_STAGE(PG8_SB(0, 0), cB, voffB); PG8_STAGE(PG8_SA(0, 0), cA, voffA); PG8_STAGE(PG8_SB(0, 1), cB + hstep, voffB); PG8_STAGE(PG8_SA(0, 1), cA + hstep, voffA);
        if (wr == 1) PG8_BAR;
        PG8_WAIT_V(4); PG8_BAR;
        PG8_STAGE(PG8_SB(1, 0), cB + kstep, voffB); PG8_STAGE(PG8_SA(1, 0), cA + kstep, voffA); PG8_STAGE(PG8_SB(1, 1), cB + hstep + kstep, voffB);
        PG8_WAIT_V(6); PG8_BAR;
    }
    for (;;) {
        const bool has_next = S.next(ui + 1, nxt);
        const char* nA = has_next ? (const char*)g.A + (size_t)nxt.pm * tstep : cA; const char* nB = has_next ? (const char*)g.Bt + (size_t)nxt.pn * tstep : cB;
        for (int t = 0; t < nt; t += 2) {
            const bool last = (t == nt - 2);
            const char* a1 = cA + (size_t)(t + 1) * kstep;
            const char* a2 = last ? nA : cA + (size_t)(t + 2) * kstep; const char* b2 = last ? nB : cB + (size_t)(t + 2) * kstep;
            const char* a3 = a2 + kstep; const char* b3 = b2 + kstep;
            if (last && has_next) S.a_ready(nxt);
            if constexpr (SP2) {
            PG8_LDB(B0, 0, 0); PG8_LDB(B1, 0, 1); PG8_SCHED; PG8_LDA(At, 0, 0); PG8_STAGE(PG8_SA(1, 1), a1 + hstep, voffA);
            PG8_WAIT_V(8); PG8_WAIT_L(0); PG8_BAR; PG8_MMA(0, 0, At, B0); PG8_MMA(0, 1, At, B1); PG8_BAR; PG8_SCHED;
            PG8_LDA(At, 0, 1); PG8_STAGE(PG8_SB(0, 0), b2, voffB); PG8_STAGE(PG8_SB(0, 1), b2 + hstep, voffB); PG8_STAGE(PG8_SA(0, 0), a2, voffA);
            PG8_WAIT_V(8); PG8_WAIT_L(0); PG8_BAR; PG8_MMA(1, 0, At, B0); PG8_MMA(1, 1, At, B1); PG8_BAR; PG8_SCHED;
            PG8_LDB(B0, 1, 0); PG8_LDB(B1, 1, 1); PG8_SCHED; PG8_LDA(At, 1, 0); PG8_STAGE(PG8_SA(0, 1), a2 + hstep, voffA);
            PG8_WAIT_V(8); PG8_WAIT_L(0); PG8_BAR; PG8_MMA(0, 0, At, B0); PG8_MMA(0, 1, At, B1); PG8_BAR; PG8_SCHED;
            PG8_LDA(At, 1, 1); PG8_STAGE(PG8_SB(1, 0), b3, voffB); PG8_STAGE(PG8_SB(1, 1), b3 + hstep, voffB); PG8_STAGE(PG8_SA(1, 0), a3, voffA);
            PG8_WAIT_V(8); PG8_WAIT_L(0); PG8_BAR; PG8_MMA(1, 0, At, B0); PG8_MMA(1, 1, At, B1); PG8_BAR; PG8_SCHED;
            } else {
            PG8_LDB(B0, 0, 0); PG8_SCHED; PG8_LDA(At, 0, 0); PG8_STAGE(PG8_SA(1, 1), a1 + hstep, voffA);
            PG8_WAIT_L(8); PG8_BAR; PG8_WAIT_L(0); PG8_MMA(0, 0, At, B0); PG8_BAR; PG8_SCHED;
            PG8_LDB(B1, 0, 1); PG8_STAGE(PG8_SB(0, 0), b2, voffB);
            PG8_BAR; PG8_WAIT_L(0); PG8_MMA(0, 1, At, B1); PG8_BAR;
            PG8_LDA(At, 0, 1); PG8_STAGE(PG8_SA(0, 0), a2, voffA);
            PG8_BAR; PG8_WAIT_L(0); PG8_MMA(1, 0, At, B0); PG8_BAR; PG8_SCHED;
            PG8_STAGE(PG8_SB(0, 1), b2 + hstep, voffB);
            PG8_WAIT_V(6); PG8_BAR; PG8_MMA(1, 1, At, B1); PG8_BAR;
            PG8_LDB(B0, 1, 0); PG8_SCHED; PG8_LDA(At, 1, 0); PG8_STAGE(PG8_SA(0, 1), a2 + hstep, voffA);
            PG8_WAIT_L(8); PG8_BAR; PG8_WAIT_L(0); PG8_MMA(0, 0, At, B0); PG8_BAR; PG8_SCHED;
            PG8_LDB(B1, 1, 1); PG8_STAGE(PG8_SB(1, 0), b3, voffB);
            PG8_BAR; PG8_WAIT_L(0); PG8_MMA(0, 1, At, B1); PG8_BAR;
            PG8_LDA(At, 1, 1); PG8_STAGE(PG8_SA(1, 0), a3, voffA);
            PG8_BAR; PG8_WAIT_L(0); PG8_MMA(1, 0, At, B0); PG8_BAR; PG8_SCHED;
            PG8_STAGE(PG8_SB(1, 1), b3 + hstep, voffB);
            PG8_WAIT_V(6); PG8_BAR; PG8_MMA(1, 1, At, B1); PG8_BAR;
            }
        }
        if constexpr (ALIGN_EPI) { if (wr == 0) PG8_BAR; }
        if constexpr (!Epi::AFTER_DRAIN) { E(acc, cur, wr, wc, fr, fq); S.done(cur); }
        if (!has_next) break;
#pragma unroll
        for (int a = 0; a < 2; ++a)
#pragma unroll
            for (int b = 0; b < 2; ++b)
#pragma unroll
                for (int m = 0; m < 4; ++m)
#pragma unroll
                    for (int n = 0; n < 2; ++n) acc[a][b][m][n] = (f32x4){0.f, 0.f, 0.f, 0.f};
        cur = nxt; cA = nA; cB = nB; ++ui;
        if constexpr (ALIGN_EPI) { if (wr == 1) PG8_BAR; }
    }
    PG8_WAIT_V(0);
    if constexpr (!ALIGN_EPI) { if (wr == 0) PG8_BAR; }
    PG8_BAR;
    if constexpr (Epi::AFTER_DRAIN) { E.fused(acc, cur, wr, wc, fr, fq, lds, wid, lane); S.done(cur); }
#undef PG8_SA
#undef PG8_SB
#undef PG8_STAGE
#undef PG8_LDA
#undef PG8_LDB
#undef PG8_MMA
#undef PG8_WAIT_V
#undef PG8_WAIT_L
#undef PG8_BAR
#undef PG8_SCHED
}
}

#ifndef PG8_SP2
#define PG8_SP2 true
#endif
#ifndef PG8_ALIGN
#define PG8_ALIGN true
#endif
#ifndef MK_PER_PHASE
#define MK_PER_PHASE 0
#endif

constexpr int S = 8192, D = 2048, FF = 5632, NL = 4, NWAVES = 8;
constexpr float EPS = 1e-6f;
constexpr float QSCALE = 0.07216878364870322f * 1.4426950408889634f;

constexpr size_t MiB = 1u << 20;
constexpr size_t WS_CTL = 0, CTL_ZERO_BYTES = 1 * MiB;
constexpr size_t WS_MOD = 1 * MiB, WS_ROPE = 2 * MiB, WS_GATE = 4 * MiB, WS_NST = 5 * MiB, WS_EST = 8 * MiB;
constexpr size_t WS_FFN1 = 24 * MiB, WS_FFN2 = 200 * MiB, WS_CIN = 288 * MiB, WS_COUT = 336 * MiB, WS_DQKV = 352 * MiB, WS_UQ = 358 * MiB, WS_UK = 363 * MiB, WS_UV = 365 * MiB,
                 WS_WO = 367 * MiB, WS_LIN = 375 * MiB, WS_LOUT = 399 * MiB;
constexpr size_t WS_H = 408 * MiB, WS_ACT = 440 * MiB, WS_MIX = 528 * MiB;
constexpr size_t WS_BG = WS_MIX, WS_CU = WS_MIX + 32 * MiB, WS_BZ = WS_MIX + 64 * MiB;
constexpr size_t WS_KVQ = WS_MIX, WS_CQN = WS_MIX + 48 * MiB, WS_CKVN = WS_MIX + 60 * MiB, WS_Q = WS_MIX + 68 * MiB, WS_K = WS_MIX + 116 * MiB, WS_VT = WS_MIX + 164 * MiB, WS_O = WS_MIX + 196 * MiB;
constexpr size_t WS_LQ = WS_MIX, WS_LK = WS_MIX + 16 * MiB, WS_LV = WS_MIX + 32 * MiB, WS_LOG = WS_MIX + 64 * MiB, WS_LH = WS_MIX + 96 * MiB, WS_LA = WS_MIX + 160 * MiB;
constexpr size_t WS_END = WS_MIX + 228 * MiB;
constexpr int CW_TMO = 0, CW_BAR = 4096;

constexpr int RING_BYTES = 131072, LDSCTL_OFF = RING_BYTES, MISC_OFF = LDSCTL_OFF + 320, LDS_BYTES = 147456;

#define GAS __attribute__((address_space(1)))
#define LAS __attribute__((address_space(3)))
typedef unsigned short bf16;
typedef unsigned v4u __attribute__((ext_vector_type(4)));
typedef unsigned v2u __attribute__((ext_vector_type(2)));
typedef float f32x4 __attribute__((ext_vector_type(4)));
typedef GAS unsigned gu32;
#define RLX_AGENT __ATOMIC_RELAXED, __HIP_MEMORY_SCOPE_AGENT
using pg8::pk2;
using pg8::u32x2;
#define XB_TMO      128
#define XB_XCNT(j)  (256  + 64 * (j))
#define XB_XSUB(j)  (1280 + 64 * (j))
#define XB_XGEN(j)  (2304 + 64 * (j))
#define XB_TOP      3328
#define XB_TOPGEN   3392
#define XCD_BAR_WORDS 3456
#define XB_SPIN_CAP (1u << 18)

__device__ __forceinline__ unsigned xb_ld(unsigned* p)              { return __hip_atomic_load(p, __ATOMIC_RELAXED, __HIP_MEMORY_SCOPE_AGENT); }
__device__ __forceinline__ unsigned xb_add(unsigned* p, unsigned v) { return __hip_atomic_fetch_add(p, v, __ATOMIC_RELAXED, __HIP_MEMORY_SCOPE_AGENT); }
__device__ __forceinline__ unsigned xb_xcc_id() { return (unsigned)__builtin_amdgcn_s_getreg((3 << 11) | 20) & 0xFu; }
#define XB_SPIN(cond, bar) do { unsigned _sp = 0; while (cond) { __builtin_amdgcn_s_sleep(1); \
    if ((++_sp & 255u) == 0u) { if (xb_ld(&(bar)[XB_TMO])) break; if (_sp > XB_SPIN_CAP) { atomicAdd(&(bar)[XB_TMO], 1u); break; } } } } while (0)

struct XcdBarrier {
    unsigned* bar; unsigned x;
    volatile LAS unsigned* st;
};

__device__ __forceinline__ XcdBarrier xcd_barrier_post(unsigned* bar, volatile LAS unsigned* st) {
    XcdBarrier b; b.bar = bar; b.x = xb_xcc_id(); b.st = st;
    if (threadIdx.x == 0) (void)xb_add(&bar[XB_XCNT(b.x)], 1u);
    return b;
}
__device__ __forceinline__ void xcd_barrier_complete(unsigned* bar, unsigned x, unsigned& nloc, unsigned& nx) {
    const unsigned G = gridDim.x * gridDim.y * gridDim.z;
    unsigned sum, cnt, mine, sp = 0u;
    for (;;) {
        sum = 0u; cnt = 0u; mine = 0u;
#pragma unroll
        for (unsigned j = 0; j < 16; ++j) { const unsigned c = xb_ld(&bar[XB_XCNT(j)]); sum += c; cnt += (c > 0u) ? 1u : 0u; mine = (j == x) ? c : mine; }
        if (sum == G) break;
        __builtin_amdgcn_s_sleep(1);
        if ((++sp & 255u) == 0u) { if (xb_ld(&bar[XB_TMO])) break; if (sp > XB_SPIN_CAP) { atomicAdd(&bar[XB_TMO], 1u); break; } }
    }
    nloc = mine > 0u ? mine : 1u; nx = cnt > 0u ? cnt : 1u;
}

__device__ __forceinline__ void xcd_barrier(const XcdBarrier& b) {
    asm volatile("s_waitcnt vmcnt(0)" ::: "memory");
    __syncthreads();
    if (threadIdx.x == 0) {
        unsigned* bar = b.bar;
        __builtin_amdgcn_s_waitcnt(0);
        unsigned nloc = b.st[0], nx = b.st[1];
        if (nloc == 0u) { xcd_barrier_complete(bar, b.x, nloc, nx); b.st[0] = nloc; b.st[1] = nx; }
        const unsigned old = xb_add(&bar[XB_XSUB(b.x)], 1u);
        const unsigned gen = old / nloc;
        if (old + 1u == (gen + 1u) * nloc) {
            __builtin_amdgcn_fence(__ATOMIC_RELEASE, "agent");
            asm volatile("s_waitcnt vmcnt(0)" ::: "memory");
            const unsigned og = xb_add(&bar[XB_TOP], 1u);
            const unsigned tg = og / nx;
            if (og + 1u == (tg + 1u) * nx) xb_add(&bar[XB_TOPGEN], 1u);
            else XB_SPIN(xb_ld(&bar[XB_TOPGEN]) == tg, bar);
            __builtin_amdgcn_fence(__ATOMIC_ACQUIRE, "agent");
            xb_add(&bar[XB_XGEN(b.x)], 1u);
            asm volatile("s_waitcnt vmcnt(0)" ::: "memory");
        } else {
            XB_SPIN(xb_ld(&bar[XB_XGEN(b.x)]) == gen, bar);
            __builtin_amdgcn_fence(__ATOMIC_ACQUIRE, "agent");
            asm volatile("s_waitcnt vmcnt(0)" ::: "memory");
        }
    }
    __syncthreads();
}


namespace attn {
typedef short bf16x8 __attribute__((ext_vector_type(8)));
typedef float f32x16 __attribute__((ext_vector_type(16)));
typedef unsigned u32x4 __attribute__((ext_vector_type(4)));
typedef unsigned u32x2 __attribute__((ext_vector_type(2)));
constexpr int S_ = 8192, NH = 16, DQK = 192, DV = 128, LDQ = NH * DQK  , LDO = NH * DV  ;
constexpr int KT_BYTES = 64 * DQK * 2  , VT_BYTES = DV * 64 * 2  , BUF_BYTES = KT_BYTES + VT_BYTES  ;
constexpr int LDS_BYTES = 2 * BUF_BYTES;

#define ATT_MFMA(a, b, c) __builtin_amdgcn_mfma_f32_32x32x16_bf16((a), (b), (c), 0, 0, 0)

__device__ __forceinline__ void attn_block(LAS unsigned char* lds, const bf16* __restrict__ Q, const bf16* __restrict__ K, const bf16* __restrict__ Vt, bf16* __restrict__ O,
                                           int head, int qb, int tid, int wave, int lane) {
    const int r = lane & 31, h = lane >> 5, x = (r >> 1) & 7;
    const int q0 = qb * 256 + wave * 32;
    const int ntiles = 4 * (qb + 1);
    unsigned ksrc[3], vsrc[2];
#pragma unroll
    for (int i = 0; i < 3; ++i) { const int p = i * 512 + tid, key = p / 24, cp = p % 24, c = (cp & ~7) | ((cp ^ (key >> 1)) & 7); ksrc[i] = (unsigned)(key * (LDQ * 2) + head * (DQK * 2) + c * 16); }
#pragma unroll
    for (int i = 0; i < 2; ++i) { const int p = i * 512 + tid, d = p >> 3, cp = p & 7, c = cp ^ ((d >> 1) & 7); vsrc[i] = (unsigned)((head * DV + d) * (S_ * 2) + c * 16); }
    unsigned koff[4], voff[4];
#pragma unroll
    for (int i = 0; i < 4; ++i) { koff[i] = (unsigned)(r * 384 + (((2 * i + h) ^ x) * 16)); voff[i] = (unsigned)(KT_BYTES + r * 128 + (((2 * i + h) ^ x) * 16)); }
    bf16x8 qf[12];
    { const bf16* qp = Q + (size_t)(q0 + r) * LDQ + head * DQK + 8 * h;
#pragma unroll
      for (int s = 0; s < 12; ++s) qf[s] = *(const bf16x8*)(qp + 16 * s); }
    f32x16 o[4];
#pragma unroll
    for (int d = 0; d < 4; ++d)
#pragma unroll
        for (int i = 0; i < 16; ++i) o[d][i] = 0.f;
    float m_run = -1e30f, l_run = 0.f;
    const char* kg = (const char*)K; const char* vg = (const char*)Vt;
    const unsigned ldsw = (unsigned)wave * 1024u;
#define ATT_STAGE(buf, t) do { const char* kt_ = kg + (size_t)(t) * (64 * LDQ * 2); const char* vt_ = vg + (size_t)(t) * 128; \
        _Pragma("unroll") for (int i_ = 0; i_ < 3; ++i_) __builtin_amdgcn_global_load_lds((const unsigned*)(kt_ + ksrc[i_]), (LAS unsigned*)(lds + (buf) * BUF_BYTES + i_ * 8192 + ldsw), 16, 0, 0); \
        _Pragma("unroll") for (int i_ = 0; i_ < 2; ++i_) __builtin_amdgcn_global_load_lds((const unsigned*)(vt_ + vsrc[i_]), (LAS unsigned*)(lds + (buf) * BUF_BYTES + KT_BYTES + i_ * 8192 + ldsw), 16, 0, 0); } while (0)
    __builtin_amdgcn_s_barrier();
    ATT_STAGE(0, 0);
    for (int t = 0; t < ntiles; ++t) {
        asm volatile("s_waitcnt vmcnt(0)" ::: "memory");
        __builtin_amdgcn_s_barrier();
        asm volatile("" ::: "memory");
        if (t + 1 < ntiles) { if ((t + 1) & 1) ATT_STAGE(1, t + 1); else ATT_STAGE(0, t + 1); }
        const int key0 = t * 64;
        if (key0 <= q0 + 31) {
            LAS unsigned char* kb_ = lds + (t & 1) * BUF_BYTES;
            f32x16 sc[2];
#pragma unroll
            for (int i = 0; i < 16; ++i) { sc[0][i] = 0.f; sc[1][i] = 0.f; }
#pragma unroll
            for (int s = 0; s < 12; ++s) {
#pragma unroll
                for (int kb = 0; kb < 2; ++kb) {
                    const bf16x8 kf = *(const LAS bf16x8*)(kb_ + koff[s & 3] + (s >> 2) * 128 + kb * (32 * 384));
                    sc[kb] = ATT_MFMA(kf, qf[s], sc[kb]);
                }
            }
            if (key0 + 63 > q0) {
                const int qrow = q0 + r;
#pragma unroll
                for (int kb = 0; kb < 2; ++kb)
#pragma unroll
                    for (int i = 0; i < 16; ++i) { const int key = key0 + 32 * kb + (i & 3) + 8 * (i >> 2) + 4 * h; sc[kb][i] = key > qrow ? -__builtin_inff() : sc[kb][i]; }
            }
            float mx = sc[0][0];
#pragma unroll
            for (int i = 1; i < 16; ++i) mx = fmaxf(mx, sc[0][i]);
#pragma unroll
            for (int i = 0; i < 16; ++i) mx = fmaxf(mx, sc[1][i]);
            mx = fmaxf(mx, __shfl_xor(mx, 32));
            const float m_new = fmaxf(m_run, mx);
            const float alpha = __builtin_amdgcn_exp2f(m_run - m_new);
            m_run = m_new;
            float ps = 0.f;
#pragma unroll
            for (int kb = 0; kb < 2; ++kb)
#pragma unroll
                for (int i = 0; i < 16; ++i) { const float p = __builtin_amdgcn_exp2f(sc[kb][i] - m_new); sc[kb][i] = p; ps += p; }
            l_run = l_run * alpha + ps;
#pragma unroll
            for (int d = 0; d < 4; ++d)
#pragma unroll
                for (int i = 0; i < 16; ++i) o[d][i] *= alpha;
            bf16x8 pf[4];
#pragma unroll
            for (int s = 0; s < 4; ++s) { u32x4 w;
                const int b = (s & 1) * 8;
                w.x = pg8::pk2(sc[s >> 1][b + 0], sc[s >> 1][b + 1]); w.y = pg8::pk2(sc[s >> 1][b + 2], sc[s >> 1][b + 3]);
                w.z = pg8::pk2(sc[s >> 1][b + 4], sc[s >> 1][b + 5]); w.w = pg8::pk2(sc[s >> 1][b + 6], sc[s >> 1][b + 7]);
                pf[s] = __builtin_bit_cast(bf16x8, w); }
#pragma unroll
            for (int d = 0; d < 4; ++d)
#pragma unroll
                for (int s = 0; s < 4; ++s) {
                    const bf16x8 vf = *(const LAS bf16x8*)(kb_ + voff[s] + d * (32 * 128));
                    o[d] = ATT_MFMA(vf, pf[s], o[d]);
                }
        }
    }
    const float l_tot = l_run + __shfl_xor(l_run, 32);
    const float inv = 1.0f / l_tot;
    bf16* op = O + (size_t)(q0 + r) * LDO + head * DV + 4 * h;
#pragma unroll
    for (int d = 0; d < 4; ++d)
#pragma unroll
        for (int g = 0; g < 4; ++g) { u32x2 w; w.x = pg8::pk2(o[d][4 * g] * inv, o[d][4 * g + 1] * inv); w.y = pg8::pk2(o[d][4 * g + 2] * inv, o[d][4 * g + 3] * inv);
            *(u32x2*)(op + 32 * d + 8 * g) = w; }
#undef ATT_STAGE
}

__device__ __forceinline__ void attn_phase(LAS unsigned char* lds, const bf16* Q, const bf16* K, const bf16* Vt, bf16* O, int G, int c, int tid, int wave, int lane) {
    for (int unit = c; unit < 256; unit += G) {
        const int head = (unit & 7) * 2 + ((unit >> 3) & 1), pair = unit >> 4;
        attn_block(lds, Q, K, Vt, O, head, pair, tid, wave, lane);
        attn_block(lds, Q, K, Vt, O, head, 31 - pair, tid, wave, lane);
    }
    asm volatile("s_waitcnt vmcnt(0)" ::: "memory");
    __builtin_amdgcn_s_barrier();
}
#undef ATT_MFMA
}

namespace mlstm {
typedef short bf16x8 __attribute__((ext_vector_type(8)));
typedef float f32x4 __attribute__((ext_vector_type(4)));
typedef unsigned u32x4 __attribute__((ext_vector_type(4)));
constexpr int S_ = 8192, NHD = 4, DK = 256, DVH = 512, DVS = 64, NSEG = 8, CPS = 16;
constexpr int OFF_QS = 0, OFF_KS = 32768, OFF_CT = 65536, OFF_VT = 98304, OFF_SW = 106496, OFF_VA = 114688, OFF_VM = OFF_VA + 4096, OFF_VF = OFF_VM + 4096,
              OFF_AMAX = OFF_VF + 4096, OFF_F63 = OFF_AMAX + 512, OFF_MST = OFF_F63 + 512, OFF_N = OFF_MST + 512, OFF_DEN = OFF_N + 1024, OFF_QN = OFF_DEN + 512, LDS_END = OFF_QN + 256;
static_assert(LDS_END <= 131072, "mlstm LDS map");
#define ML_MFMA(a, b, c) __builtin_amdgcn_mfma_f32_16x16x32_bf16((a), (b), (c), 0, 0, 0)
__device__ __forceinline__ float fexp(float x) { return __builtin_amdgcn_exp2f(x * 1.4426950408889634f); }
__device__ __forceinline__ float wave_incl_sum(float v, int lane) {
#pragma unroll
    for (int o = 1; o < 64; o <<= 1) { const float t = __shfl_up(v, o); if (lane >= o) v += t; }
    return v; }
__device__ __forceinline__ float wave_incl_max(float v, int lane) {
#pragma unroll
    for (int o = 1; o < 64; o <<= 1) { const float t = __shfl_up(v, o); if (lane >= o) v = fmaxf(v, t); }
    return v; }
__device__ __forceinline__ float bflo(unsigned w) { return __uint_as_float(w << 16); }
__device__ __forceinline__ float bfhi(unsigned w) { return __uint_as_float(w & 0xffff0000u); }
__device__ __forceinline__ float bfel(const u32x4& v, int e) { const unsigned w = v[e >> 1]; return (e & 1) ? bfhi(w) : bflo(w); }
__device__ __forceinline__ int sw512(int row, int c) { return row * 512 + (((c & 16) | ((c ^ row) & 15)) << 4); }
__device__ __forceinline__ int sw128(int row, int c) { return row * 128 + ((c ^ ((row >> 1) & 7)) << 4); }

template <int PASS>
__device__ __forceinline__ void seg_pass(LAS unsigned char* lds, const bf16* __restrict__ Qg, const bf16* __restrict__ Kg, const bf16* __restrict__ Vg,
                                         const float* __restrict__ ipre, const float* __restrict__ logf, float* __restrict__ Est, float* __restrict__ Nst, float* __restrict__ hout,
                                         int unit, int tid, int wave, int lane) {
    const int xcd = unit & 7, jj = unit >> 3, ds = jj & 7, idx = xcd * 4 + (jj >> 3), hd = idx >> 3, sg = idx & 7;
    const int l15 = lane & 15, kq = lane >> 4;
    LAS float* VA = (LAS float*)(lds + OFF_VA); LAS float* VM = (LAS float*)(lds + OFF_VM); LAS float* VF = (LAS float*)(lds + OFF_VF);
    LAS float* AMAX = (LAS float*)(lds + OFF_AMAX); LAS float* F63 = (LAS float*)(lds + OFF_F63); LAS float* MST = (LAS float*)(lds + OFF_MST);
    LAS float* NS = (LAS float*)(lds + OFF_N); LAS float* DEN = (LAS float*)(lds + OFF_DEN); LAS float* QN = (LAS float*)(lds + OFF_QN);
    const float* ip_h = ipre + (size_t)hd * S_; const float* lf_h = logf + (size_t)hd * S_;
    for (int c = wave; c < 128; c += 8) {
        const float lf = lf_h[c * 64 + lane], ip = ip_h[c * 64 + lane];
        const float fc = wave_incl_sum(lf, lane), a = ip - fc, am = wave_incl_max(a, lane);
        if (lane == 63) { F63[c] = fc; AMAX[c] = am; }
    }
    __syncthreads();
    if (tid == 0) { float m = 0.f; for (int c = 0; c < 128; ++c) { MST[c] = m; m = F63[c] + fmaxf(m, AMAX[c]); } }
    __syncthreads();
#pragma unroll
    for (int t = 0; t < 2; ++t) { const int cc = wave * 2 + t, c = sg * CPS + cc;
        const float lf = lf_h[c * 64 + lane], ip = ip_h[c * 64 + lane];
        const float fc = wave_incl_sum(lf, lane), a = ip - fc, pm = wave_incl_max(a, lane);
        VA[cc * 64 + lane] = a; VM[cc * 64 + lane] = fmaxf(MST[c], pm); VF[cc * 64 + lane] = fc; }
    f32x4 C[2][4];
#pragma unroll
    for (int a = 0; a < 2; ++a)
#pragma unroll
        for (int b = 0; b < 4; ++b) C[a][b] = (f32x4){0.f, 0.f, 0.f, 0.f};
    float nreg = 0.f;
    if (PASS == 2) {
        for (int sp = 0; sp < sg; ++sp) {
            float ld = 0.f;
            for (int c = sp * CPS; c < (sp + 1) * CPS; ++c) ld += MST[c] - fmaxf(MST[c], AMAX[c]);
            const float D = fexp(ld);
            const float* e = Est + ((((size_t)(hd * NSEG + sp) * 8 + ds) * 8 + wave) * 64 + lane) * 32;
#pragma unroll
            for (int a = 0; a < 2; ++a)
#pragma unroll
                for (int b = 0; b < 4; ++b) { const f32x4 ev = *(const f32x4*)(e + (a * 4 + b) * 4); C[a][b] = C[a][b] * D + ev; }
            if (tid < 256) nreg = nreg * D + Nst[(size_t)(hd * NSEG + sp) * 256 + tid];
        }
    }
    if (tid < 256) NS[tid] = nreg;
    __syncthreads();
    const bf16* qb = Qg + hd * DK; const bf16* kb = Kg + hd * DK; const bf16* vb = Vg + hd * DVH + ds * DVS;
    const int jt = wave >> 1, t0 = 2 * (wave & 1);
    for (int cc = 0; cc < CPS; ++cc) {
        const int c = sg * CPS + cc, pos0 = c * 64;
        const float mst = MST[c], M63 = VM[cc * 64 + 63], decay = fexp(mst - M63);
        u32x4 kreg[2][2], vreg[2], qreg[4];
#pragma unroll
        for (int i = 0; i < 2; ++i) { const int qd = i * 512 + tid, sp = qd >> 5, cch = qd & 31;
            kreg[i][0] = *(const u32x4*)(kb + (size_t)(pos0 + 2 * sp) * 1024 + 8 * cch); kreg[i][1] = *(const u32x4*)(kb + (size_t)(pos0 + 2 * sp + 1) * 1024 + 8 * cch); }
        if (tid < 256) { const int sp = tid >> 3, cch = tid & 7;
            vreg[0] = *(const u32x4*)(vb + (size_t)(pos0 + 2 * sp) * 2048 + 8 * cch); vreg[1] = *(const u32x4*)(vb + (size_t)(pos0 + 2 * sp + 1) * 2048 + 8 * cch); }
        if (PASS == 2) {
#pragma unroll
            for (int i = 0; i < 4; ++i) { const int p = i * 512 + tid, j = p >> 5, cch = p & 31; qreg[i] = *(const u32x4*)(qb + (size_t)(pos0 + j) * 1024 + 8 * cch); }
        }
        __syncthreads();
        if (tid < 256) { const int sp = tid >> 3, cch = tid & 7, s0 = 2 * sp;
#pragma unroll
            for (int e = 0; e < 8; ++e) { const int dv = 8 * cch + e; const unsigned w0 = vreg[0][e >> 1], w1 = vreg[1][e >> 1];
                const unsigned pr = (e & 1) ? ((w0 >> 16) | (w1 & 0xffff0000u)) : ((w0 & 0xffffu) | (w1 << 16));
                *(LAS unsigned*)(lds + OFF_VT + sw128(dv, s0 >> 3) + (s0 & 7) * 2) = pr; } }
        if (PASS == 2) {
#pragma unroll
            for (int i = 0; i < 4; ++i) { const int p = i * 512 + tid, j = p >> 5, cch = p & 31; *(LAS u32x4*)(lds + OFF_QS + sw512(j, cch)) = qreg[i]; }
#pragma unroll
            for (int i = 0; i < 2; ++i) { const int qd = i * 512 + tid, sp = qd >> 5, cch = qd & 31;
                *(LAS u32x4*)(lds + OFF_KS + sw512(2 * sp, cch)) = kreg[i][0]; *(LAS u32x4*)(lds + OFF_KS + sw512(2 * sp + 1, cch)) = kreg[i][1]; }
#pragma unroll
            for (int a = 0; a < 2; ++a)
#pragma unroll
                for (int b = 0; b < 4; ++b) { const int dv = 16 * b + l15, chunk = 4 * wave + 2 * a + (kq >> 1);
                    u32x2 w; w.x = pg8::pk2(C[a][b][0], C[a][b][1]); w.y = pg8::pk2(C[a][b][2], C[a][b][3]);
                    *(LAS u32x2*)(lds + OFF_CT + sw512(dv, chunk) + (kq & 1) * 8) = w; }
        }
        __syncthreads();
        f32x4 qc0 = {0.f, 0.f, 0.f, 0.f}, qc1 = {0.f, 0.f, 0.f, 0.f};
        if (PASS == 2) {
            f32x4 s0 = {0.f, 0.f, 0.f, 0.f}, s1 = {0.f, 0.f, 0.f, 0.f};
            const int rq = 16 * jt + l15, r0 = 16 * t0 + l15, r1 = r0 + 16;
#pragma unroll
            for (int ks = 0; ks < 8; ++ks) { const int ch = 4 * ks + kq;
                const bf16x8 aq = *(const LAS bf16x8*)(lds + OFF_QS + sw512(rq, ch));
                const bf16x8 bk0 = *(const LAS bf16x8*)(lds + OFF_KS + sw512(r0, ch)), bk1 = *(const LAS bf16x8*)(lds + OFF_KS + sw512(r1, ch));
                const bf16x8 bc0 = *(const LAS bf16x8*)(lds + OFF_CT + sw512(r0, ch)), bc1 = *(const LAS bf16x8*)(lds + OFF_CT + sw512(r1, ch));
                s0 = ML_MFMA(aq, bk0, s0); s1 = ML_MFMA(aq, bk1, s1); qc0 = ML_MFMA(aq, bc0, qc0); qc1 = ML_MFMA(aq, bc1, qc1);
                if (ks & 1) asm volatile("" ::: "memory"); }
            const float a0 = VA[cc * 64 + r0], a1 = VA[cc * 64 + r1];
            float rp[4];
#pragma unroll
            for (int rg = 0; rg < 4; ++rg) { const int j = 16 * jt + 4 * kq + rg; const float Mj = VM[cc * 64 + j];
                const float w0 = (r0 <= j) ? fexp(a0 - Mj) : 0.f, w1 = (r1 <= j) ? fexp(a1 - Mj) : 0.f;
                const float v0 = s0[rg] * w0, v1 = s1[rg] * w1; rp[rg] = v0 + v1;
                *(LAS unsigned short*)(lds + OFF_SW + sw128(j, r0 >> 3) + (r0 & 7) * 2) = (unsigned short)(pg8::pk2(v0, 0.f) & 0xffffu);
                *(LAS unsigned short*)(lds + OFF_SW + sw128(j, r1 >> 3) + (r1 & 7) * 2) = (unsigned short)(pg8::pk2(v1, 0.f) & 0xffffu); }
#pragma unroll
            for (int rg = 0; rg < 4; ++rg) { float v = rp[rg]; v += __shfl_xor(v, 1); v += __shfl_xor(v, 2); v += __shfl_xor(v, 4); v += __shfl_xor(v, 8);
                if (l15 == 0) DEN[(16 * jt + 4 * kq + rg) * 2 + (wave & 1)] = v; }
            { const int j = tid >> 3, part = tid & 7; float acc = 0.f;
#pragma unroll
              for (int cq = 0; cq < 4; ++cq) { const u32x4 qv = *(const LAS u32x4*)(lds + OFF_QS + sw512(j, 4 * part + cq));
#pragma unroll
                  for (int e = 0; e < 8; ++e) acc += bfel(qv, e) * NS[32 * part + 8 * cq + e]; }
              acc += __shfl_xor(acc, 1); acc += __shfl_xor(acc, 2); acc += __shfl_xor(acc, 4);
              if (part == 0) QN[j] = acc; }
            __syncthreads();
        }
#pragma unroll
        for (int i = 0; i < 2; ++i) { const int qd = i * 512 + tid, sp = qd >> 5, cch = qd & 31, s0i = 2 * sp;
            const float ws0 = fexp(VA[cc * 64 + s0i] - M63), ws1 = fexp(VA[cc * 64 + s0i + 1] - M63);
#pragma unroll
            for (int e = 0; e < 8; ++e) { const int dk = 8 * cch + e; const float k0 = bfel(kreg[i][0], e) * ws0, k1 = bfel(kreg[i][1], e) * ws1;
                *(LAS unsigned*)(lds + OFF_KS + sw128(dk, s0i >> 3) + (s0i & 7) * 2) = pg8::pk2(k0, k1); } }
        if (PASS == 2) {
            f32x4 n0 = {0.f, 0.f, 0.f, 0.f}, n1 = {0.f, 0.f, 0.f, 0.f};
            const int rq = 16 * jt + l15, r0 = 16 * t0 + l15, r1 = r0 + 16;
#pragma unroll
            for (int ks = 0; ks < 2; ++ks) { const int ch = 4 * ks + kq;
                const bf16x8 as = *(const LAS bf16x8*)(lds + OFF_SW + sw128(rq, ch));
                const bf16x8 bv0 = *(const LAS bf16x8*)(lds + OFF_VT + sw128(r0, ch)), bv1 = *(const LAS bf16x8*)(lds + OFF_VT + sw128(r1, ch));
                n0 = ML_MFMA(as, bv0, n0); n1 = ML_MFMA(as, bv1, n1); }
#pragma unroll
            for (int rg = 0; rg < 4; ++rg) { const int j = 16 * jt + 4 * kq + rg; const float Mj = VM[cc * 64 + j], fj = VF[cc * 64 + j];
                const float wi = fexp(mst - Mj), den = DEN[j * 2] + DEN[j * 2 + 1] + wi * QN[j];
                const float dd = fmaxf(fabsf(den), fexp(-(fj + Mj))), inv = 1.0f / dd;
                float* hp = hout + (size_t)(pos0 + j) * 2048 + hd * DVH + ds * DVS;
                hp[r0] = (n0[rg] + wi * qc0[rg]) * inv; hp[r1] = (n1[rg] + wi * qc1[rg]) * inv; }
        }
        __syncthreads();
#pragma unroll
        for (int a = 0; a < 2; ++a)
#pragma unroll
            for (int b = 0; b < 4; ++b) C[a][b] = C[a][b] * decay;
#pragma unroll
        for (int ks = 0; ks < 2; ++ks) { const int ch = 4 * ks + kq;
            bf16x8 bv[4];
#pragma unroll
            for (int b = 0; b < 4; ++b) bv[b] = *(const LAS bf16x8*)(lds + OFF_VT + sw128(16 * b + l15, ch));
#pragma unroll
            for (int a = 0; a < 2; ++a) { const bf16x8 ak = *(const LAS bf16x8*)(lds + OFF_KS + sw128(32 * wave + 16 * a + l15, ch));
#pragma unroll
                for (int b = 0; b < 4; ++b) C[a][b] = ML_MFMA(ak, bv[b], C[a][b]); } }
        if (tid < 256) { float acc = 0.f;
#pragma unroll
            for (int cq = 0; cq < 8; ++cq) { const u32x4 kv = *(const LAS u32x4*)(lds + OFF_KS + tid * 128 + cq * 16);
#pragma unroll
                for (int e = 0; e < 8; ++e) acc += bfel(kv, e); }
            nreg = nreg * decay + acc; NS[tid] = nreg; }
    }
    if (PASS == 1) {
        float* e = Est + ((((size_t)(hd * NSEG + sg) * 8 + ds) * 8 + wave) * 64 + lane) * 32;
#pragma unroll
        for (int a = 0; a < 2; ++a)
#pragma unroll
            for (int b = 0; b < 4; ++b) *(f32x4*)(e + (a * 4 + b) * 4) = C[a][b];
        if (ds == 0 && tid < 256) Nst[(size_t)(hd * NSEG + sg) * 256 + tid] = nreg;
    }
    __syncthreads();
}
#undef ML_MFMA
}

__device__ __forceinline__ float wave_sum(float v) {
#pragma unroll
    for (int o = 1; o < 64; o <<= 1) v += __shfl_xor(v, o);
    return v;
}
__device__ __forceinline__ float bf_lo(unsigned w) { return __uint_as_float(w << 16); }
__device__ __forceinline__ float bf_hi(unsigned w) { return __uint_as_float(w & 0xffff0000u); }

template <bool GATES>
__device__ __forceinline__ void norm_phase(LAS unsigned char* lds, int gw, int ngw, int tid, int lane, const float* __restrict__ xin, const float* __restrict__ g,
                                           const float* __restrict__ sc, const float* __restrict__ sh, bf16* __restrict__ hout,
                                           const float* __restrict__ wlin, const float* __restrict__ bgate, float* __restrict__ ipre, float* __restrict__ logf) {
    LAS float* GE = (LAS float*)lds; LAS float* SH = GE + D; LAS float* WG = SH + D;
    for (int i = tid; i < D; i += NWAVES * 64) { GE[i] = g[i] * (1.0f + sc[i]); SH[i] = sh[i]; }
    if (GATES) { for (int i = tid; i < D * 8; i += NWAVES * 64) WG[i] = wlin[(size_t)(i >> 3) * 6152 + 6144 + (i & 7)]; }
    __syncthreads();
    for (int m = gw; m < S; m += ngw) {
        const GAS f32x4* xr = (const GAS f32x4*)(xin + (size_t)m * D) + lane;
        f32x4 v[8]; float ss = 0.f;
#pragma unroll
        for (int j = 0; j < 8; ++j) { v[j] = xr[64 * j]; ss += (v[j].x * v[j].x + v[j].y * v[j].y) + (v[j].z * v[j].z + v[j].w * v[j].w); }
        const float rstd = 1.0f / sqrtf(wave_sum(ss) * (1.0f / D) + EPS);
        GAS v2u* o8 = (GAS v2u*)(hout + (size_t)m * D) + lane;
        float ga[8];
        if (GATES) {
#pragma unroll
            for (int q = 0; q < 8; ++q) ga[q] = 0.f; }
#pragma unroll
        for (int j = 0; j < 8; ++j) { const int col = 4 * lane + 256 * j; const f32x4 ge = *(const LAS f32x4*)(GE + col), sv = *(const LAS f32x4*)(SH + col);
            const f32x4 hv = v[j] * rstd * ge + sv; v2u w; w.x = pk2(hv.x, hv.y); w.y = pk2(hv.z, hv.w); o8[64 * j] = w;
            if (GATES) {
#pragma unroll
                for (int e = 0; e < 4; ++e) { const f32x4 w0 = *(const LAS f32x4*)(WG + (col + e) * 8), w1 = *(const LAS f32x4*)(WG + (col + e) * 8 + 4); const float he = hv[e];
                    ga[0] += he * w0.x; ga[1] += he * w0.y; ga[2] += he * w0.z; ga[3] += he * w0.w; ga[4] += he * w1.x; ga[5] += he * w1.y; ga[6] += he * w1.z; ga[7] += he * w1.w; }
                asm volatile("" ::: "memory"); } }
        if (GATES) {
#pragma unroll
            for (int q = 0; q < 8; ++q) ga[q] = wave_sum(ga[q]);
            float mine = ga[0];
#pragma unroll
            for (int q = 1; q < 8; ++q) mine = (lane == q) ? ga[q] : mine;
            if (lane < 8) { float gv = mine + bgate[lane]; gv = 15.0f * tanhf(gv * (1.0f / 15.0f));
                if (lane < 4) ipre[(size_t)lane * S + m] = gv;
                else { const float ls = fminf(gv, 0.f) - log1pf(expf(-fabsf(gv))); logf[(size_t)(lane - 4) * S + m] = ls; } } }
    }
}
__device__ __forceinline__ void conv_phase(int gw, int ngw, int lane, const bf16* __restrict__ BG, const bf16* __restrict__ CU, const float* __restrict__ cw, bf16* __restrict__ BZ) {
    for (int m = gw; m < S; m += ngw) {
#pragma unroll
        for (int j = 0; j < 4; ++j) { const int col = 8 * lane + 512 * j;
            const v4u b = *(const GAS v4u*)(BG + (size_t)m * D + col), c2 = *(const GAS v4u*)(CU + (size_t)m * D + col);
            v4u c1 = {0u, 0u, 0u, 0u}, c0 = {0u, 0u, 0u, 0u};
            if (m >= 1) c1 = *(const GAS v4u*)(CU + (size_t)(m - 1) * D + col);
            if (m >= 2) c0 = *(const GAS v4u*)(CU + (size_t)(m - 2) * D + col);
            float w0[8], w1[8], w2[8];
#pragma unroll
            for (int q = 0; q < 2; ++q) { const f32x4 a0 = *(const GAS f32x4*)(cw + col + 4 * q), a1 = *(const GAS f32x4*)(cw + D + col + 4 * q), a2 = *(const GAS f32x4*)(cw + 2 * D + col + 4 * q);
#pragma unroll
                for (int e = 0; e < 4; ++e) { w0[4 * q + e] = a0[e]; w1[4 * q + e] = a1[e]; w2[4 * q + e] = a2[e]; } }
            v4u o;
#pragma unroll
            for (int q = 0; q < 4; ++q) {
                const float z0 = w0[2 * q] * bf_lo(c0[q]) + w1[2 * q] * bf_lo(c1[q]) + w2[2 * q] * bf_lo(c2[q]);
                const float z1 = w0[2 * q + 1] * bf_hi(c0[q]) + w1[2 * q + 1] * bf_hi(c1[q]) + w2[2 * q + 1] * bf_hi(c2[q]);
                o[q] = pk2(bf_lo(b[q]) * z0, bf_hi(b[q]) * z1); }
            *(GAS v4u*)(BZ + (size_t)m * D + col) = o; }
    }
}
__device__ __forceinline__ void mla2_phase(int gw, int ngw, int lane, const float* __restrict__ KVQ, const float* __restrict__ gq, const float* __restrict__ gkv,
                                           const float* __restrict__ cs, const float* __restrict__ sn, bf16* __restrict__ CQN, bf16* __restrict__ CKVN, bf16* __restrict__ Kc) {
    for (int m = gw; m < S; m += ngw) {
        const float* row = KVQ + (size_t)m * 1536;
        f32x4 q[3], kv[2]; float sq = 0.f, sk = 0.f;
#pragma unroll
        for (int j = 0; j < 3; ++j) { q[j] = *(const GAS f32x4*)(row + 4 * lane + 256 * j); sq += (q[j].x * q[j].x + q[j].y * q[j].y) + (q[j].z * q[j].z + q[j].w * q[j].w); }
#pragma unroll
        for (int j = 0; j < 2; ++j) { kv[j] = *(const GAS f32x4*)(row + 768 + 4 * lane + 256 * j); sk += (kv[j].x * kv[j].x + kv[j].y * kv[j].y) + (kv[j].z * kv[j].z + kv[j].w * kv[j].w); }
        const float rq = 1.0f / sqrtf(wave_sum(sq) * (1.0f / 768.0f) + EPS), rk = 1.0f / sqrtf(wave_sum(sk) * (1.0f / 512.0f) + EPS);
#pragma unroll
        for (int j = 0; j < 3; ++j) { const f32x4 gg = *(const GAS f32x4*)(gq + 4 * lane + 256 * j); const f32x4 o = q[j] * rq * gg; v2u w; w.x = pk2(o.x, o.y); w.y = pk2(o.z, o.w);
            *(GAS v2u*)(CQN + (size_t)m * 768 + 4 * lane + 256 * j) = w; }
#pragma unroll
        for (int j = 0; j < 2; ++j) { const f32x4 gg = *(const GAS f32x4*)(gkv + 4 * lane + 256 * j); const f32x4 o = kv[j] * rk * gg; v2u w; w.x = pk2(o.x, o.y); w.y = pk2(o.z, o.w);
            *(GAS v2u*)(CKVN + (size_t)m * 512 + 4 * lane + 256 * j) = w; }
        const int i = lane & 31; const float x1 = row[1280 + i], x2 = row[1280 + 32 + i], c = cs[(size_t)m * 32 + i], s = sn[(size_t)m * 32 + i];
        const float y1 = x1 * c - x2 * s, y2 = x1 * s + x2 * c;
        const int a = lane & 7;
        const float p0 = __shfl(y1, 4 * a), p1 = __shfl(y1, 4 * a + 1), p2 = __shfl(y1, 4 * a + 2), p3 = __shfl(y1, 4 * a + 3);
        const float r0 = __shfl(y2, 4 * a), r1 = __shfl(y2, 4 * a + 1), r2 = __shfl(y2, 4 * a + 2), r3 = __shfl(y2, 4 * a + 3);
        v4u w; w.x = pk2(p0, p1); w.y = pk2(p2, p3); w.z = pk2(r0, r1); w.w = pk2(r2, r3);
        const int hg = lane >> 3;
        *(GAS v4u*)(Kc + (size_t)m * 3072 + hg * 192 + 128 + 8 * a) = w;
        *(GAS v4u*)(Kc + (size_t)m * 3072 + (hg + 8) * 192 + 128 + 8 * a) = w;
    }
}
__device__ __forceinline__ void mlstm5_phase(int gw, int ngw, int lane, const float* __restrict__ HO, const bf16* __restrict__ OG, const float* __restrict__ gn, bf16* __restrict__ A) {
    for (int m = gw; m < S; m += ngw) {
        const GAS f32x4* hr = (const GAS f32x4*)(HO + (size_t)m * D) + lane;
        f32x4 v[8]; float ss[4];
#pragma unroll
        for (int j = 0; j < 8; ++j) v[j] = hr[64 * j];
#pragma unroll
        for (int hd = 0; hd < 4; ++hd) { const f32x4 a = v[2 * hd], b = v[2 * hd + 1];
            ss[hd] = wave_sum((a.x * a.x + a.y * a.y) + (a.z * a.z + a.w * a.w) + (b.x * b.x + b.y * b.y) + (b.z * b.z + b.w * b.w)); }
#pragma unroll
        for (int j = 0; j < 8; ++j) { const int col = 4 * lane + 256 * j; const float rstd = 1.0f / sqrtf(ss[j >> 1] * (1.0f / 512.0f) + EPS);
            const f32x4 gg = *(const GAS f32x4*)(gn + col); const v2u og = *(const GAS v2u*)(OG + (size_t)m * D + col);
            const f32x4 o = v[j] * rstd * gg; v2u w; w.x = pk2(o.x * bf_lo(og.x), o.y * bf_hi(og.x)); w.y = pk2(o.z * bf_lo(og.y), o.w * bf_hi(og.y));
            *(GAS v2u*)(A + (size_t)m * D + col) = w; }
    }
}
__device__ __forceinline__ void final_phase(int gw, int ngw, int lane, float* __restrict__ x, const float* __restrict__ g) {
    for (int m = gw; m < S; m += ngw) {
        GAS f32x4* xr = (GAS f32x4*)(x + (size_t)m * D) + lane;
        f32x4 v[8]; float ss = 0.f;
#pragma unroll
        for (int j = 0; j < 8; ++j) { v[j] = xr[64 * j]; ss += (v[j].x * v[j].x + v[j].y * v[j].y) + (v[j].z * v[j].z + v[j].w * v[j].w); }
        const float rstd = 1.0f / sqrtf(wave_sum(ss) * (1.0f / D) + EPS);
#pragma unroll
        for (int j = 0; j < 8; ++j) { const f32x4 gg = *(const GAS f32x4*)(g + 4 * lane + 256 * j); xr[64 * j] = v[j] * rstd * gg; }
    }
}

__device__ const float ROPE_INVF[32] = {1.000000000e+00f, 7.498942614e-01f, 5.623413324e-01f, 4.216965139e-01f, 3.162277639e-01f, 2.371373773e-01f, 1.778279394e-01f, 1.333521307e-01f,
    1.000000015e-01f, 7.498941571e-02f, 5.623413250e-02f, 4.216965288e-02f, 3.162277490e-02f, 2.371373773e-02f, 1.778279431e-02f, 1.333521493e-02f,
    9.999999776e-03f, 7.498941850e-03f, 5.623413250e-03f, 4.216964822e-03f, 3.162277630e-03f, 2.371373586e-03f, 1.778279431e-03f, 1.333521446e-03f,
    1.000000047e-03f, 7.498942432e-04f, 5.623413017e-04f, 4.216965172e-04f, 3.162277571e-04f, 2.371373703e-04f, 1.778279402e-04f, 1.333521504e-04f};
__device__ __forceinline__ void sincos_f64(double x, float& s, float& c) {
    const double k = __builtin_rint(x * 0.63661977236758134308);
    double r = __builtin_fma(-k, 1.57079632679489655800e+00, x); r = __builtin_fma(-k, 6.12323399573676603587e-17, r);
    const double r2 = r * r;
    double sp = -7.6471637318198164759e-13; sp = sp * r2 + 1.6059043836821614599e-10; sp = sp * r2 - 2.5052108385441718775e-08; sp = sp * r2 + 2.7557319223985890653e-06;
    sp = sp * r2 - 1.9841269841269841270e-04; sp = sp * r2 + 8.3333333333333333333e-03; sp = sp * r2 - 1.6666666666666666667e-01; sp = r + r * r2 * sp;
    double cp = 4.7794773323873852974e-14; cp = cp * r2 - 1.1470745597729724714e-11; cp = cp * r2 + 2.0876756987868098979e-09; cp = cp * r2 - 2.7557319223985890653e-07;
    cp = cp * r2 + 2.4801587301587301587e-05; cp = cp * r2 - 1.3888888888888888889e-03; cp = cp * r2 + 4.1666666666666666667e-02; cp = 1.0 - 0.5 * r2 + r2 * r2 * cp;
    const int q = ((int)k) & 3;
    const double sv = (q == 0) ? sp : (q == 1) ? cp : (q == 2) ? -sp : -cp;
    const double cv = (q == 0) ? cp : (q == 1) ? -sp : (q == 2) ? -cp : sp;
    s = (float)sv; c = (float)cv;
}

enum { WK_FFN1 = 0, WK_FFN2, WK_CIN, WK_COUT, WK_DQKV, WK_UQ, WK_UK, WK_UV, WK_WO, WK_LIN, WK_LOUT };
struct Inputs { const float* in[25]; };
template <int KIND> __device__ __forceinline__ const float* src_col(const Inputs& I, int idx, int n, int& ld) {
    if (KIND == WK_FFN1) { const int pn = n >> 8, bj = (n >> 7) & 1, f = 128 * pn + (n & 127); ld = FF; return I.in[bj ? 8 : 7] + (size_t)idx * D * FF + f; }
    if (KIND == WK_FFN2) { ld = D; return I.in[9] + (size_t)idx * FF * D + n; }
    if (KIND == WK_CIN) { ld = 3 * D; int col = n; if (n >= D) { const int t = n - D, pn = t >> 8, bj = (t >> 7) & 1; col = D + bj * D + 128 * pn + (t & 127); } return I.in[10] + (size_t)idx * D * 3 * D + col; }
    if (KIND == WK_COUT) { ld = D; return I.in[12] + (size_t)idx * D * D + n; }
    if (KIND == WK_DQKV) { if (n < 768) { ld = 768; return I.in[13] + n; } if (n < 1344) { ld = 576; return I.in[16] + (n - 768); } ld = 0; return nullptr; }
    if (KIND == WK_UQ) { ld = 3072; const int head = n / 192, w = n - head * 192; int col = n; if (w >= 128) { const int r = w - 128, a = r >> 3, nn = (r >> 2) & 1, b = r & 3; col = head * 192 + 128 + nn * 32 + 4 * a + b; } return I.in[15] + col; }
    if (KIND == WK_UK) { ld = 4096; return I.in[18] + (n >> 7) * 256 + (n & 127); }
    if (KIND == WK_UV) { ld = 4096; return I.in[18] + (n >> 7) * 256 + 128 + (n & 127); }
    if (KIND == WK_WO) { ld = D; return I.in[19] + n; }
    if (KIND == WK_LIN) { ld = 6152; return I.in[20] + n; }
    ld = D; return I.in[23] + n;
}
template <int KIND> __device__ __forceinline__ void xpose_matrix(const Inputs& I, int idx, bf16* __restrict__ WT, int K, int N, LAS float* scr, int gw, int ngw, int lane) {
    const int nblk = N / 32, nitems = (K / 64) * nblk;
    for (int it = gw; it < nitems; it += ngw) {
        const int kb = it / nblk, nb = it - kb * nblk, k0 = 64 * kb, n0 = 32 * nb;
        int ld; const float* cp = src_col<KIND>(I, idx, n0 + (lane & 31), ld);
#pragma unroll 8
        for (int i = 0; i < 32; ++i) { const int kk = 2 * i + (lane >> 5); scr[kk * 33 + (lane & 31)] = cp ? cp[(size_t)(k0 + kk) * ld] : 0.f; }
        asm volatile("s_waitcnt lgkmcnt(0)" ::: "memory");
        const int c = lane & 7;
#pragma unroll
        for (int j = 0; j < 4; ++j) { const int n = (lane >> 3) + 8 * j; const LAS float* s = scr + (8 * c) * 33 + n;
            v4u o; o.x = pk2(s[0 * 33], s[1 * 33]); o.y = pk2(s[2 * 33], s[3 * 33]); o.z = pk2(s[4 * 33], s[5 * 33]); o.w = pk2(s[6 * 33], s[7 * 33]);
            *(GAS v4u*)(WT + (size_t)(n0 + n) * K + k0 + 8 * c) = o; }
        asm volatile("s_waitcnt lgkmcnt(0)" ::: "memory");
    }
}
__device__ __forceinline__ void prologue(const Inputs& I, unsigned char* ws, LAS unsigned char* lds, int vcu, int G, int tid, int wave, int lane) {
    const int gw = vcu * NWAVES + wave, ngw = G * NWAVES;
    LAS float* CA = (LAS float*)(lds + 81920); LAS float* RED = (LAS float*)(lds + 90112);
    for (int i = tid; i < D; i += NWAVES * 64) { const float cv = I.in[1][i]; CA[i] = cv / (1.0f + expf(-cv)); }
    __syncthreads();
    float* MOD = (float*)(ws + WS_MOD);
    for (int task = vcu; task < NL * 192; task += G) {
        const int l = task / 192, cb = task - l * 192, kq = lane >> 4, c4 = lane & 15;
        const float* wp = I.in[3] + ((size_t)l * D + 256 * wave + kq) * (6 * D) + 64 * cb + 4 * c4;
        f32x4 acc = {0.f, 0.f, 0.f, 0.f};
#pragma unroll 8
        for (int i = 0; i < 64; ++i) { const f32x4 w = *(const GAS f32x4*)(wp + (size_t)(4 * i) * (6 * D)); acc += w * CA[256 * wave + 4 * i + kq]; }
#pragma unroll
        for (int e = 0; e < 4; ++e) { float v = acc[e]; v += __shfl_xor(v, 16); v += __shfl_xor(v, 32); acc[e] = v; }
        if (kq == 0) *(LAS f32x4*)(RED + wave * 64 + 4 * c4) = acc;
        __syncthreads();
        if (tid < 64) { float v = 0.f;
#pragma unroll
            for (int w = 0; w < 8; ++w) v += RED[w * 64 + tid];
            MOD[(size_t)l * 6 * D + 64 * cb + tid] = v + I.in[4][(size_t)l * 6 * D + 64 * cb + tid]; }
        __syncthreads();
    }
    { float* cs = (float*)(ws + WS_ROPE); float* sn = cs + S * 32; const int* pos = (const int*)I.in[2];
      for (int idx = (vcu * NWAVES * 64) + tid; idx < S * 32; idx += G * NWAVES * 64) { const int s = idx >> 5, i = idx & 31;
          const float ang = (float)pos[s] * ROPE_INVF[i]; float sv, cv; sincos_f64((double)ang, sv, cv);
          cs[idx] = cv; sn[idx] = sv; } }
    LAS float* scr = (LAS float*)(lds + wave * 8448);
    for (int l = 0; l < NL; ++l) xpose_matrix<WK_FFN1>(I, l, (bf16*)(ws + WS_FFN1 + (size_t)l * 44 * MiB), D, 2 * FF, scr, gw, ngw, lane);
    for (int l = 0; l < NL; ++l) xpose_matrix<WK_FFN2>(I, l, (bf16*)(ws + WS_FFN2 + (size_t)l * 22 * MiB), FF, D, scr, gw, ngw, lane);
    for (int j = 0; j < 2; ++j) xpose_matrix<WK_CIN>(I, j, (bf16*)(ws + WS_CIN + (size_t)j * 24 * MiB), D, 3 * D, scr, gw, ngw, lane);
    for (int j = 0; j < 2; ++j) xpose_matrix<WK_COUT>(I, j, (bf16*)(ws + WS_COUT + (size_t)j * 8 * MiB), D, D, scr, gw, ngw, lane);
    xpose_matrix<WK_DQKV>(I, 0, (bf16*)(ws + WS_DQKV), D, 1536, scr, gw, ngw, lane);
    xpose_matrix<WK_UQ>(I, 0, (bf16*)(ws + WS_UQ), 768, 3072, scr, gw, ngw, lane);
    xpose_matrix<WK_UK>(I, 0, (bf16*)(ws + WS_UK), 512, 2048, scr, gw, ngw, lane);
    xpose_matrix<WK_UV>(I, 0, (bf16*)(ws + WS_UV), 512, 2048, scr, gw, ngw, lane);
    xpose_matrix<WK_WO>(I, 0, (bf16*)(ws + WS_WO), D, D, scr, gw, ngw, lane);
    xpose_matrix<WK_LIN>(I, 0, (bf16*)(ws + WS_LIN), D, 3 * D, scr, gw, ngw, lane);
    xpose_matrix<WK_LOUT>(I, 0, (bf16*)(ws + WS_LOUT), D, D, scr, gw, ngw, lane);
}

#ifndef NO_ATTN
#define NO_ATTN 0
#endif
#ifndef NO_ML1
#define NO_ML1 0
#endif
#ifndef NO_ML2
#define NO_ML2 0
#endif
#ifndef NO_PRO
#define NO_PRO 0
#endif
#ifndef NO_NG
#define NO_NG 0
#endif
struct Args { Inputs I; float* out; unsigned char* ws; int ph_lo, ph_hi; };
constexpr int N_PHASES = 34;

template <class Epi> __device__ __forceinline__ void run_gemm(LAS unsigned char* lds, const bf16* A, const bf16* Bt, int M, int N, int K, int G, int c, const Epi& E) {
    pg8::Gemm g{A, Bt, M, N, K}; pg8::StaticOrder So; So.init(M, N, G, c);
    pg8::gemm_phase<Epi, pg8::StaticOrder, PG8_ALIGN, PG8_SP2>(lds, g, So, E);
}

__global__ void __launch_bounds__(NWAVES * 64, 2) trunk_fwd(Args args) {
    extern __shared__ __attribute__((aligned(16))) unsigned char lds_raw[];
    LAS unsigned char* lds = (LAS unsigned char*)lds_raw;
    volatile LAS unsigned* MISC = (volatile LAS unsigned*)(lds + MISC_OFF);
    const int tid = threadIdx.x, lane = tid & 63, wave = __builtin_amdgcn_readfirstlane(tid >> 6);
    const int G = gridDim.x, bx = blockIdx.x, vcu = (G % 8 == 0) ? (bx % 8) * (G / 8) + bx / 8 : bx;
    const int gw = vcu * NWAVES + wave, ngw = G * NWAVES;
    unsigned char* ws = args.ws; gu32* ctl = (gu32*)(ws + WS_CTL);
    for (int u = tid; u < (LDS_BYTES - LDSCTL_OFF) / 4; u += NWAVES * 64) ((LAS unsigned*)(lds + LDSCTL_OFF))[u] = 0u;
    __syncthreads();
    XcdBarrier bar; bar.bar = (unsigned*)(ctl + CW_BAR); bar.x = 0; bar.st = nullptr;
    if (!MK_PER_PHASE) bar = xcd_barrier_post((unsigned*)(ctl + CW_BAR), MISC + 8);
    const int lo = args.ph_lo, hi = args.ph_hi;
    int ph = 0;
#define PHASE_BEGIN if (lo <= ph && ph < hi) {
#define PHASE_END   if (!MK_PER_PHASE && ph + 1 < hi) xcd_barrier(bar); } ++ph;
    const Inputs& I = args.I;
    float* X = args.out;
    float* MOD = (float*)(ws + WS_MOD);
    const float* CS = (const float*)(ws + WS_ROPE); const float* SN = CS + S * 32;
    float* IPRE = (float*)(ws + WS_GATE); float* LOGF = IPRE + 4 * S;
    bf16* H = (bf16*)(ws + WS_H); bf16* ACT = (bf16*)(ws + WS_ACT);

    PHASE_BEGIN if (!NO_PRO) prologue(I, ws, lds, vcu, G, tid, wave, lane); PHASE_END

#define MODV(l, k) (MOD + (size_t)(l) * 6 * D + (k) * D)
#define FFN_PHASES(l) \
    PHASE_BEGIN norm_phase<false>(lds, gw, ngw, tid, lane, X, I.in[6] + (l) * D, MODV(l, 4), MODV(l, 3), H, nullptr, nullptr, nullptr, nullptr); PHASE_END \
    PHASE_BEGIN { pg8::EpiSwiGLU E{ACT, FF}; run_gemm(lds, H, (const bf16*)(ws + WS_FFN1 + (size_t)(l) * 44 * MiB), S, 2 * FF, D, G, bx, E); } PHASE_END \
    PHASE_BEGIN { pg8::EpiResid E{X, X, MODV(l, 5), D}; run_gemm(lds, ACT, (const bf16*)(ws + WS_FFN2 + (size_t)(l) * 22 * MiB), S, D, FF, G, bx, E); } PHASE_END
#define CONV_PHASES(l, j, XIN) \
    PHASE_BEGIN norm_phase<false>(lds, gw, ngw, tid, lane, XIN, I.in[5] + (l) * D, MODV(l, 1), MODV(l, 0), H, nullptr, nullptr, nullptr, nullptr); PHASE_END \
    PHASE_BEGIN { pg8::EpiConvIn E{(bf16*)(ws + WS_BG), (bf16*)(ws + WS_CU), D}; run_gemm(lds, H, (const bf16*)(ws + WS_CIN + (size_t)(j) * 24 * MiB), S, 3 * D, D, G, bx, E); } PHASE_END \
    PHASE_BEGIN conv_phase(gw, ngw, lane, (const bf16*)(ws + WS_BG), (const bf16*)(ws + WS_CU), I.in[11] + (j) * 3 * D, (bf16*)(ws + WS_BZ)); PHASE_END \
    PHASE_BEGIN { pg8::EpiResid E{XIN, X, MODV(l, 2), D}; run_gemm(lds, (const bf16*)(ws + WS_BZ), (const bf16*)(ws + WS_COUT + (size_t)(j) * 8 * MiB), S, D, D, G, bx, E); } PHASE_END

    CONV_PHASES(0, 0, I.in[0])
    FFN_PHASES(0)
    PHASE_BEGIN norm_phase<false>(lds, gw, ngw, tid, lane, X, I.in[5] + 1 * D, MODV(1, 1), MODV(1, 0), H, nullptr, nullptr, nullptr, nullptr); PHASE_END
    PHASE_BEGIN { pg8::EpiF32 E{(float*)(ws + WS_KVQ), 1536}; run_gemm(lds, H, (const bf16*)(ws + WS_DQKV), S, 1536, D, G, bx, E); } PHASE_END
    PHASE_BEGIN mla2_phase(gw, ngw, lane, (const float*)(ws + WS_KVQ), I.in[14], I.in[17], CS, SN, (bf16*)(ws + WS_CQN), (bf16*)(ws + WS_CKVN), (bf16*)(ws + WS_K)); PHASE_END
    PHASE_BEGIN {
        { pg8::EpiQRope E{(bf16*)(ws + WS_Q), 3072, QSCALE, CS, SN}; run_gemm(lds, (const bf16*)(ws + WS_CQN), (const bf16*)(ws + WS_UQ), S, 3072, 768, G, bx, E); }
        { pg8::EpiKnope E{(bf16*)(ws + WS_K), 3072}; run_gemm(lds, (const bf16*)(ws + WS_CKVN), (const bf16*)(ws + WS_UK), S, 2048, 512, G, bx, E); }
        { pg8::EpiVt E{(bf16*)(ws + WS_VT), S}; run_gemm(lds, (const bf16*)(ws + WS_UV), (const bf16*)(ws + WS_CKVN), 2048, S, 512, G, bx, E); }
    } PHASE_END
    PHASE_BEGIN if (!NO_ATTN) attn::attn_phase(lds, (const bf16*)(ws + WS_Q), (const bf16*)(ws + WS_K), (const bf16*)(ws + WS_VT), (bf16*)(ws + WS_O), G, bx, tid, wave, lane); PHASE_END
    PHASE_BEGIN { pg8::EpiResid E{X, X, MODV(1, 2), D}; run_gemm(lds, (const bf16*)(ws + WS_O), (const bf16*)(ws + WS_WO), S, D, D, G, bx, E); } PHASE_END
    FFN_PHASES(1)
    PHASE_BEGIN if (!NO_NG) norm_phase<true>(lds, gw, ngw, tid, lane, X, I.in[5] + 2 * D, MODV(2, 1), MODV(2, 0), H, I.in[20], I.in[21], IPRE, LOGF); PHASE_END
    PHASE_BEGIN { pg8::EpiMlstmIn E{(bf16*)(ws + WS_LQ), (bf16*)(ws + WS_LK), (bf16*)(ws + WS_LV), (bf16*)(ws + WS_LOG), 0.0625f}; run_gemm(lds, H, (const bf16*)(ws + WS_LIN), S, 3 * D, D, G, bx, E); } PHASE_END
    PHASE_BEGIN if (!NO_ML1) for (int u = bx; u < 256; u += G) mlstm::seg_pass<1>(lds, (const bf16*)(ws + WS_LQ), (const bf16*)(ws + WS_LK), (const bf16*)(ws + WS_LV), IPRE, LOGF, (float*)(ws + WS_EST), (float*)(ws + WS_NST), (float*)(ws + WS_LH), u, tid, wave, lane); PHASE_END
    PHASE_BEGIN if (!NO_ML2) for (int u = bx; u < 256; u += G) mlstm::seg_pass<2>(lds, (const bf16*)(ws + WS_LQ), (const bf16*)(ws + WS_LK), (const bf16*)(ws + WS_LV), IPRE, LOGF, (float*)(ws + WS_EST), (float*)(ws + WS_NST), (float*)(ws + WS_LH), u, tid, wave, lane); PHASE_END
    PHASE_BEGIN mlstm5_phase(gw, ngw, lane, (const float*)(ws + WS_LH), (const bf16*)(ws + WS_LOG), I.in[22], (bf16*)(ws + WS_LA)); PHASE_END
    PHASE_BEGIN { pg8::EpiResid E{X, X, MODV(2, 2), D}; run_gemm(lds, (const bf16*)(ws + WS_LA), (const bf16*)(ws + WS_LOUT), S, D, D, G, bx, E); } PHASE_END
    FFN_PHASES(2)
    CONV_PHASES(3, 1, X)
    FFN_PHASES(3)
    PHASE_BEGIN final_phase(gw, ngw, lane, X, I.in[24]); PHASE_END
#undef PHASE_BEGIN
#undef PHASE_END
}

extern "C" void kernel_launch(void* const* d_in, const int* in_sizes, int n_in, void* d_out, int out_size, void* d_ws, size_t ws_size, hipStream_t stream) {
    static int grid = 0;
    if (grid == 0) {
        if (n_in != 25 || out_size != S * D || ws_size < WS_END) { fprintf(stderr, "kernel_launch: unexpected shapes (n_in %d, out %d, ws %zu < %zu)\n", n_in, out_size, ws_size, (size_t)WS_END); grid = -1; return; }
        int dev = 0, cus = 0, per_cu = 0;
        if (hipGetDevice(&dev) != hipSuccess || hipDeviceGetAttribute(&cus, hipDeviceAttributeMultiprocessorCount, dev) != hipSuccess) { grid = -1; return; }
        if (hipFuncSetAttribute((const void*)trunk_fwd, hipFuncAttributeMaxDynamicSharedMemorySize, LDS_BYTES) != hipSuccess) { fprintf(stderr, "kernel_launch: hipFuncSetAttribute failed\n"); grid = -1; return; }
        if (hipOccupancyMaxActiveBlocksPerMultiprocessor(&per_cu, (const void*)trunk_fwd, NWAVES * 64, LDS_BYTES) != hipSuccess || per_cu < 1) { fprintf(stderr, "kernel_launch: occupancy query says %d\n", per_cu); }
        (void)hipGetLastError();
        grid = cus;
    }
    if (grid < 0) return;
    if (hipMemsetAsync((char*)d_ws + WS_CTL, 0, CTL_ZERO_BYTES, stream) != hipSuccess) return;
    Args a{};
    for (int i = 0; i < 25; ++i) a.I.in[i] = (const float*)d_in[i];
    a.out = (float*)d_out; a.ws = (unsigned char*)d_ws;
#if MK_PER_PHASE
    for (int p = 0; p < N_PHASES; ++p) { a.ph_lo = p; a.ph_hi = p + 1; hipLaunchKernelGGL(trunk_fwd, dim3(grid), dim3(NWAVES * 64), LDS_BYTES, stream, a); }
#else
    a.ph_lo = 0; a.ph_hi = N_PHASES; hipLaunchKernelGGL(trunk_fwd, dim3(grid), dim3(NWAVES * 64), LDS_BYTES, stream, a);
#endif
}
```

```cpp
#include <hip/hip_runtime.h>
#include <hip/hip_bf16.h>
#include <cstdio>
#include <cstdint>
#include <cmath>
namespace pg8 {
#define PG8_LAS __attribute__((address_space(3)))
typedef unsigned short bf16_t;
typedef short bf16x8 __attribute__((ext_vector_type(8)));
typedef float f32x4 __attribute__((ext_vector_type(4)));
typedef unsigned u32x4 __attribute__((ext_vector_type(4)));
constexpr int BM = 256, BK = 64, HALF = 128, HTB = HALF * BK * 2  , STAGE_BYTES = 8 * HTB, NXCD = 8, WGM = 8;

__host__ __device__ __forceinline__ int lds_byte(int r, int c) { const int st = (r >> 4) * 2 + (c >> 5), rr = r & 15, cc = c & 31, ob = rr * 64 + cc * 2; return st * 1024 + (ob ^ (((ob >> 9) & 1) << 5)); }
__host__ __device__ __forceinline__ void stage_rc(int b, int& R, int& C) { const int st = b / 1024, sb = b % 1024, swz = sb ^ (((sb >> 9) & 1) << 5); R = (st >> 1) * 16 + swz / 64; C = (st & 1) * 32 + (swz % 64) / 2; }
__host__ __device__ __forceinline__ int perm32(int rho) { const int n = rho >> 4, i = rho & 15; return 8 * (i >> 2) + 4 * n + (i & 3); }

struct Unit { int pm, pn; };
struct Gemm { const bf16_t* A; const bf16_t* Bt; int M, N, K; };

struct StaticOrder {
    int nM, nN, nwg, G, c;
    __host__ __device__ void init(int M, int N, int G_, int c_) { nM = M / BM; nN = N / BM; nwg = nM * nN; G = G_; c = c_; }
    __host__ __device__ bool next(int i, Unit& u) const {
        const long L = (long)i * G + c; if (L >= nwg) return false;
        int wgid = (int)L; { const int q = nwg / NXCD, r = nwg % NXCD, xcd = wgid % NXCD, off = wgid / NXCD; wgid = (xcd < r ? xcd * (q + 1) : r * (q + 1) + (xcd - r) * q) + off; }
        const int nig = WGM * nN, gid = wgid / nig, fm = gid * WGM, gsz = (nM - fm) < WGM ? (nM - fm) : WGM;
        u.pm = fm + ((wgid % nig) % gsz); u.pn = (wgid % nig) / gsz; return true;
    }
    __device__ __forceinline__ void a_ready(const Unit&) const {}
    __device__ __forceinline__ void done(const Unit&) const {}
};

typedef float f32x2 __attribute__((ext_vector_type(2)));
typedef __bf16 bf16x2_t __attribute__((ext_vector_type(2)));
typedef unsigned u32x2 __attribute__((ext_vector_type(2)));
__device__ __forceinline__ unsigned pk2(float lo, float hi) { f32x2 v = {lo, hi}; bf16x2_t r = __builtin_convertvector(v, bf16x2_t); return __builtin_bit_cast(unsigned, r); }
__device__ __forceinline__ u32x4 pk8(const f32x4& a, const f32x4& b) { u32x4 w; w.x = pk2(a[0], a[1]); w.y = pk2(a[2], a[3]); w.z = pk2(b[0], b[1]); w.w = pk2(b[2], b[3]); return w; }
__device__ __forceinline__ float fsigmoid(float v) { return __builtin_amdgcn_rcpf(1.0f + __builtin_amdgcn_exp2f(-1.44269504089f * v)); }
__device__ __forceinline__ float fsilu(float v) { return v * fsigmoid(v); }

struct EpiResid {
    static constexpr bool PERM = false, AFTER_DRAIN = false;
    const float* base; float* out; const float* gate; int ldc;
    __device__ __forceinline__ void operator()(const f32x4 (&acc)[2][2][4][2], const Unit& u, int wr, int wc, int fr, int fq) const {
        const int row0 = u.pm * BM + wr * 64 + fr, col0 = u.pn * BM + wc * 32 + 4 * fq;
        f32x4 gv[2][2];
#pragma unroll
        for (int bj = 0; bj < 2; ++bj)
#pragma unroll
            for (int n = 0; n < 2; ++n) gv[bj][n] = *(const f32x4*)(gate + col0 + bj * HALF + n * 16);
#pragma unroll
        for (int ai = 0; ai < 2; ++ai)
#pragma unroll
            for (int m = 0; m < 4; ++m) { const size_t off = (size_t)(row0 + ai * HALF + m * 16) * ldc + col0;
#pragma unroll
                for (int bj = 0; bj < 2; ++bj)
#pragma unroll
                    for (int n = 0; n < 2; ++n) { const f32x4 b = *(const f32x4*)(base + off + bj * HALF + n * 16); *(f32x4*)(out + off + bj * HALF + n * 16) = b + gv[bj][n] * acc[ai][bj][m][n]; } }
    }
};
struct EpiF32 {
    static constexpr bool PERM = false, AFTER_DRAIN = false;
    float* C; int ldc;
    __device__ __forceinline__ void operator()(const f32x4 (&acc)[2][2][4][2], const Unit& u, int wr, int wc, int fr, int fq) const {
        const int row0 = u.pm * BM + wr * 64 + fr, col0 = u.pn * BM + wc * 32 + 4 * fq;
#pragma unroll
        for (int ai = 0; ai < 2; ++ai)
#pragma unroll
            for (int m = 0; m < 4; ++m) { float* rowp = C + (size_t)(row0 + ai * HALF + m * 16) * ldc + col0;
#pragma unroll
                for (int bj = 0; bj < 2; ++bj)
#pragma unroll
                    for (int n = 0; n < 2; ++n) *(f32x4*)(rowp + bj * HALF + n * 16) = acc[ai][bj][m][n]; }
    }
};
struct EpiSwiGLU {
    static constexpr bool PERM = true, AFTER_DRAIN = false;
    bf16_t* O; int ldc;
    __device__ __forceinline__ void operator()(const f32x4 (&acc)[2][2][4][2], const Unit& u, int wr, int wc, int fr, int fq) const {
        const int row0 = u.pm * BM + wr * 64 + fr, col0 = u.pn * HALF + wc * 32 + 8 * fq;
#pragma unroll
        for (int ai = 0; ai < 2; ++ai)
#pragma unroll
            for (int m = 0; m < 4; ++m) { bf16_t* rowp = O + (size_t)(row0 + ai * HALF + m * 16) * ldc + col0;
                f32x4 v0, v1;
#pragma unroll
                for (int j = 0; j < 4; ++j) { v0[j] = fsilu(acc[ai][0][m][0][j]) * acc[ai][1][m][0][j]; v1[j] = fsilu(acc[ai][0][m][1][j]) * acc[ai][1][m][1][j]; }
                *(u32x4*)rowp = pk8(v0, v1); }
    }
};
struct EpiConvIn {
    static constexpr bool PERM = true, AFTER_DRAIN = false;
    bf16_t* BG; bf16_t* CU; int ldc;
    __device__ __forceinline__ void operator()(const f32x4 (&acc)[2][2][4][2], const Unit& u, int wr, int wc, int fr, int fq) const {
        const int row0 = u.pm * BM + wr * 64 + fr;
        if (u.pn < 8) {
            const int col0 = u.pn * BM + wc * 32 + 8 * fq;
#pragma unroll
            for (int ai = 0; ai < 2; ++ai)
#pragma unroll
                for (int m = 0; m < 4; ++m) { bf16_t* rowp = BG + (size_t)(row0 + ai * HALF + m * 16) * ldc + col0;
#pragma unroll
                    for (int bj = 0; bj < 2; ++bj) *(u32x4*)(rowp + bj * HALF) = pk8(acc[ai][bj][m][0], acc[ai][bj][m][1]); }
        } else {
            const int col0 = (u.pn - 8) * HALF + wc * 32 + 8 * fq;
#pragma unroll
            for (int ai = 0; ai < 2; ++ai)
#pragma unroll
                for (int m = 0; m < 4; ++m) { bf16_t* rowp = CU + (size_t)(row0 + ai * HALF + m * 16) * ldc + col0;
                    *(u32x4*)rowp = pk8(acc[ai][0][m][0] * acc[ai][1][m][0], acc[ai][0][m][1] * acc[ai][1][m][1]); }
        }
    }
};
struct EpiMlstmIn {
    static constexpr bool PERM = true, AFTER_DRAIN = false;
    bf16_t* Q; bf16_t* K; bf16_t* V; bf16_t* OG; float kscale;
    __device__ __forceinline__ void operator()(const f32x4 (&acc)[2][2][4][2], const Unit& u, int wr, int wc, int fr, int fq) const {
        const int row0 = u.pm * BM + wr * 64 + fr; bf16_t* base; int ldc, colt; float sc = 1.f; bool sig = false;
        if (u.pn < 4) { base = Q; ldc = 1024; colt = u.pn * BM; }
        else if (u.pn < 8) { base = K; ldc = 1024; colt = (u.pn - 4) * BM; sc = kscale; }
        else if (u.pn < 16) { base = V; ldc = 2048; colt = (u.pn - 8) * BM; }
        else { base = OG; ldc = 2048; colt = (u.pn - 16) * BM; sig = true; }
        const int col0 = colt + wc * 32 + 8 * fq;
#pragma unroll
        for (int ai = 0; ai < 2; ++ai)
#pragma unroll
            for (int m = 0; m < 4; ++m) { bf16_t* rowp = base + (size_t)(row0 + ai * HALF + m * 16) * ldc + col0;
#pragma unroll
                for (int bj = 0; bj < 2; ++bj) { f32x4 v0 = acc[ai][bj][m][0] * sc, v1 = acc[ai][bj][m][1] * sc;
                    if (sig) {
#pragma unroll
                        for (int j = 0; j < 4; ++j) { v0[j] = fsigmoid(v0[j]); v1[j] = fsigmoid(v1[j]); } }
                    *(u32x4*)(rowp + bj * HALF) = pk8(v0, v1); } }
    }
};
struct EpiQRope {
    static constexpr bool PERM = true, AFTER_DRAIN = false;
    bf16_t* Q; int ldc; float qscale; const float* cs; const float* sn;
    __device__ __forceinline__ void operator()(const f32x4 (&acc)[2][2][4][2], const Unit& u, int wr, int wc, int fr, int fq) const {
        const int row0 = u.pm * BM + wr * 64 + fr, col0 = u.pn * BM + wc * 32 + 8 * fq;
#pragma unroll
        for (int bj = 0; bj < 2; ++bj) {
            const int gi = u.pn * 8 + bj * 4 + wc, g6 = gi % 6;
            if (g6 < 4) {
#pragma unroll
                for (int ai = 0; ai < 2; ++ai)
#pragma unroll
                    for (int m = 0; m < 4; ++m) { bf16_t* rowp = Q + (size_t)(row0 + ai * HALF + m * 16) * ldc + col0 + bj * HALF;
                        *(u32x4*)rowp = pk8(acc[ai][bj][m][0] * qscale, acc[ai][bj][m][1] * qscale); }
            } else {
                const int i0 = 16 * (g6 - 4) + 4 * fq;
#pragma unroll
                for (int ai = 0; ai < 2; ++ai)
#pragma unroll
                    for (int m = 0; m < 4; ++m) { const int row = row0 + ai * HALF + m * 16; bf16_t* rowp = Q + (size_t)row * ldc + col0 + bj * HALF;
                        const f32x4 c = *(const f32x4*)(cs + (size_t)row * 32 + i0), s = *(const f32x4*)(sn + (size_t)row * 32 + i0);
                        const f32x4 x1 = acc[ai][bj][m][0] * qscale, x2 = acc[ai][bj][m][1] * qscale;
                        *(u32x4*)rowp = pk8(x1 * c - x2 * s, x1 * s + x2 * c); }
            }
        }
    }
};
struct EpiKnope {
    static constexpr bool PERM = true, AFTER_DRAIN = false;
    bf16_t* Kc; int ldc;
    __device__ __forceinline__ void operator()(const f32x4 (&acc)[2][2][4][2], const Unit& u, int wr, int wc, int fr, int fq) const {
        const int row0 = u.pm * BM + wr * 64 + fr;
#pragma unroll
        for (int ai = 0; ai < 2; ++ai)
#pragma unroll
            for (int m = 0; m < 4; ++m) { bf16_t* rowp = Kc + (size_t)(row0 + ai * HALF + m * 16) * ldc + wc * 32 + 8 * fq;
#pragma unroll
                for (int bj = 0; bj < 2; ++bj) *(u32x4*)(rowp + (2 * u.pn + bj) * 192) = pk8(acc[ai][bj][m][0], acc[ai][bj][m][1]); }
    }
};
struct EpiVt {
    static constexpr bool PERM = false, AFTER_DRAIN = false;
    bf16_t* Vt; int ldc;
    __device__ __forceinline__ void operator()(const f32x4 (&acc)[2][2][4][2], const Unit& u, int wr, int wc, int fr, int fq) const {
        const int row0 = u.pm * BM + wr * 64 + fr, fqs = ((fq & 1) << 1) | (fq >> 1), col0 = u.pn * BM + wc * 32 + 4 * fqs;
#pragma unroll
        for (int ai = 0; ai < 2; ++ai)
#pragma unroll
            for (int m = 0; m < 4; ++m) { bf16_t* rowp = Vt + (size_t)(row0 + ai * HALF + m * 16) * ldc + col0;
#pragma unroll
                for (int bj = 0; bj < 2; ++bj)
#pragma unroll
                    for (int n = 0; n < 2; ++n) { const f32x4 v = acc[ai][bj][m][n]; u32x2 w; w.x = pk2(v[0], v[1]); w.y = pk2(v[2], v[3]); *(u32x2*)(rowp + bj * HALF + n * 16) = w; } }
    }
};

template <class Epi, class Sched, bool ALIGN_EPI = false, bool SP2 = false>
__device__ __forceinline__ void gemm_phase(PG8_LAS unsigned char* lds, const Gemm g, const Sched& S, const Epi& E) {
    const int tid = threadIdx.x, wid = __builtin_amdgcn_readfirstlane(tid >> 6), lane = tid & 63, wr = wid >> 2, wc = wid & 3, fr = lane & 15, fq = lane >> 4;
    const int K = g.K, nt = K / BK;
    unsigned voffA[2], voffB[2];
#pragma unroll
    for (int i = 0; i < 2; ++i) { int R, C; stage_rc(tid * 16 + i * 8192, R, C); const int Rb = Epi::PERM ? ((R & ~31) + perm32(R & 31)) : R;
        voffA[i] = (unsigned)(R * K + C) * 2u; voffB[i] = (unsigned)(Rb * K + C) * 2u; }
    const size_t kstep = (size_t)(BK * 2);
    const size_t hstep = (size_t)HALF * K * 2;
    const size_t tstep = 2 * hstep;
    const unsigned ldsw = (unsigned)wid * 1024u;
    const int aoff = lds_byte(wr * 64 + fr, fq * 8), boff = lds_byte(wc * 32 + fr, fq * 8);
#define PG8_SA(b, h) (((b) * 2 + (h)) * HTB)
#define PG8_SB(b, h) ((4 + (b) * 2 + (h)) * HTB)
#define PG8_STAGE(bufoff, gbase, voff) do { _Pragma("unroll") for (int _i = 0; _i < 2; ++_i) \
        __builtin_amdgcn_global_load_lds((const unsigned*)((const char*)(gbase) + (voff)[_i]), (PG8_LAS unsigned*)(lds + (bufoff) + ldsw + _i * 8192), 16, 0, 0); } while (0)
#define PG8_LDA(dst, b, h) do { _Pragma("unroll") for (int m = 0; m < 4; ++m) _Pragma("unroll") for (int k = 0; k < 2; ++k) dst[m][k] = *(const PG8_LAS bf16x8*)(lds + PG8_SA(b, h) + aoff + m * 2048 + k * 1024); } while (0)
#define PG8_LDB(dst, b, h) do { _Pragma("unroll") for (int n = 0; n < 2; ++n) _Pragma("unroll") for (int k = 0; k < 2; ++k) dst[n][k] = *(const PG8_LAS bf16x8*)(lds + PG8_SB(b, h) + boff + n * 2048 + k * 1024); } while (0)
#define PG8_MMA(ai, bj, At, Bt) do { __builtin_amdgcn_s_setprio(1); _Pragma("unroll") for (int m = 0; m < 4; ++m) _Pragma("unroll") for (int n = 0; n < 2; ++n) _Pragma("unroll") for (int k = 0; k < 2; ++k) \
        acc[ai][bj][m][n] = __builtin_amdgcn_mfma_f32_16x16x32_bf16(Bt[n][k], At[m][k], acc[ai][bj][m][n], 0, 0, 0); __builtin_amdgcn_s_setprio(0); } while (0)
#define PG8_WAIT_V(n) asm volatile("s_waitcnt vmcnt(" #n ")" ::: "memory")
#define PG8_WAIT_L(n) asm volatile("s_waitcnt lgkmcnt(" #n ")" ::: "memory")
#define PG8_BAR __builtin_amdgcn_s_barrier()
#define PG8_SCHED __builtin_amdgcn_sched_barrier(0)
    Unit cur, nxt; int ui = 0;
    if (!S.next(0, cur)) return;
    f32x4 acc[2][2][4][2];
#pragma unroll
    for (int a = 0; a < 2; ++a)
#pragma unroll
        for (int b = 0; b < 2; ++b)
#pragma unroll
            for (int m = 0; m < 4; ++m)
#pragma unroll
                for (int n = 0; n < 2; ++n) acc[a][b][m][n] = (f32x4){0.f, 0.f, 0.f, 0.f};
    bf16x8 At[4][2], B0[2][2], B1[2][2];
    const char* cA = (const char*)g.A + (size_t)cur.pm * tstep; const char* cB = (const char*)g.Bt + (size_t)cur.pn * tstep;
    S.a_ready(cur);
    if constexpr (SP2) {
        PG8_STAGE(PG8_SB(0, 0), cB, voffB); PG8_STAGE(PG8_SB(0, 1), cB + hstep, voffB); PG8_STAGE(PG8_SA(0, 0), cA, voffA); PG8_STAGE(PG8_SA(0, 1), cA + hstep, voffA);
        if (wr == 1) PG8_BAR;
        PG8_WAIT_V(2); PG8_BAR;
        PG8_STAGE(PG8_SB(1, 0), cB + kstep, voffB); PG8_STAGE(PG8_SA(1, 0), cA + kstep, voffA); PG8_STAGE(PG8_SB(1, 1), cB + hstep + kstep, voffB);
        PG8_WAIT_V(6); PG8_BAR;
    } else {
        PG8_STAGE(PG8_SB(0, 0), cB, voffB); PG8_STAGE(PG8_SA(0, 0), cA, voffA); PG8_STAGE(PG8_SB(0, 1), cB + hstep, voffB); PG8_STAGE(PG8_SA(0, 1), cA + hstep, voffA);
        if (wr == 1) PG8_BAR;
        PG8_WAIT_V(4); PG8_BAR;
        PG8_STAGE(PG8_SB(1, 0), cB + kstep, voffB); PG8_STAGE(PG8_SA(1, 0), cA + kstep, voffA); PG8_STAGE(PG8_SB(1, 1), cB + hstep + kstep, voffB);
        PG8_WAIT_V(6); PG8_BAR;
    }
    for (;;) {
        const bool has_next = S.next(ui + 1, nxt);
        const char* nA = has_next ? (const char*)g.A + (size_t)nxt.pm * tstep : cA; const char* nB = has_next ? (const char*)g.Bt + (size_t)nxt.pn * tstep : cB;
        for (int t = 0; t < nt; t += 2) {
            const bool last = (t == nt - 2);
            const char* a1 = cA + (size_t)(t + 1) * kstep;
            const char* a2 = last ? nA : cA + (size_t)(t + 2) * kstep; const char* b2 = last ? nB : cB + (size_t)(t + 2) * kstep;
            const char* a3 = a2 + kstep; const char* b3 = b2 + kstep;
            if (last && has_next) S.a_ready(nxt);
            if constexpr (SP2) {
            PG8_LDB(B0, 0, 0); PG8_LDB(B1, 0, 1); PG8_SCHED; PG8_LDA(At, 0, 0); PG8_STAGE(PG8_SA(1, 1), a1 + hstep, voffA);
            PG8_WAIT_V(8); PG8_WAIT_L(0); PG8_BAR; PG8_MMA(0, 0, At, B0); PG8_MMA(0, 1, At, B1); PG8_BAR; PG8_SCHED;
            PG8_LDA(At, 0, 1); PG8_STAGE(PG8_SB(0, 0), b2, voffB); PG8_STAGE(PG8_SB(0, 1), b2 + hstep, voffB); PG8_STAGE(PG8_SA(0, 0), a2, voffA);
            PG8_WAIT_V(8); PG8_WAIT_L(0); PG8_BAR; PG8_MMA(1, 0, At, B0); PG8_MMA(1, 1, At, B1); PG8_BAR; PG8_SCHED;
            PG8_LDB(B0, 1, 0); PG8_LDB(B1, 1, 1); PG8_SCHED; PG8_LDA(At, 1, 0); PG8_STAGE(PG8_SA(0, 1), a2 + hstep, voffA);
            PG8_WAIT_V(8); PG8_WAIT_L(0); PG8_BAR; PG8_MMA(0, 0, At, B0); PG8_MMA(0, 1, At, B1); PG8_BAR; PG8_SCHED;
            PG8_LDA(At, 1, 1); PG8_STAGE(PG8_SB(1, 0), b3, voffB); PG8_STAGE(PG8_SB(1, 1), b3 + hstep, voffB); PG8_STAGE(PG8_SA(1, 0), a3, voffA);
            PG8_WAIT_V(8); PG8_WAIT_L(0); PG8_BAR; PG8_MMA(1, 0, At, B0); PG8_MMA(1, 1, At, B1); PG8_BAR; PG8_SCHED;
            } else {
            PG8_LDB(B0, 0, 0); PG8_SCHED; PG8_LDA(At, 0, 0); PG8_STAGE(PG8_SA(1, 1), a1 + hstep, voffA);
            PG8_WAIT_L(8); PG8_BAR; PG8_WAIT_L(0); PG8_MMA(0, 0, At, B0); PG8_BAR; PG8_SCHED;
            PG8_LDB(B1, 0, 1); PG8_STAGE(PG8_SB(0, 0), b2, voffB);
            PG8_BAR; PG8_WAIT_L(0); PG8_MMA(0, 1, At, B1); PG8_BAR;
            PG8_LDA(At, 0, 1); PG8_STAGE(PG8_SA(0, 0), a2, voffA);
            PG8_BAR; PG8_WAIT_L(0); PG8_MMA(1, 0, At, B0); PG8_BAR; PG8_SCHED;
            PG8_STAGE(PG8_SB(0, 1), b2 + hstep, voffB);
            PG8_WAIT_V(6); PG8_BAR; PG8_MMA(1, 1, At, B1); PG8_BAR;
            PG8_LDB(B0, 1, 0); PG8_SCHED; PG8_LDA(At, 1, 0); PG8_STAGE(PG8_SA(0, 1), a2 + hstep, voffA);
            PG8_WAIT_L(8); PG8_BAR; PG8_WAIT_L(0); PG8_MMA(0, 0, At, B0); PG8_BAR; PG8_SCHED;
            PG8_LDB(B1, 1, 1); PG8_STAGE(PG8_SB(1, 0), b3, voffB);
            PG8_BAR; PG8_WAIT_L(0); PG8_MMA(0, 1, At, B1); PG8_BAR;
            PG8_LDA(At, 1, 1); PG8_STAGE(PG8_SA(1, 0), a3, voffA);
            PG8_BAR; PG8_WAIT_L(0); PG8_MMA(1, 0, At, B0); PG8_BAR; PG8_SCHED;
            PG8_STAGE(PG8_SB(1, 1), b3 + hstep, voffB);
            PG8_WAIT_V(6); PG8_BAR; PG8_MMA(1, 1, At, B1); PG8_BAR;
            }
        }
        if constexpr (ALIGN_EPI) { if (wr == 0) PG8_BAR; }
        if constexpr (!Epi::AFTER_DRAIN) { E(acc, cur, wr, wc, fr, fq); S.done(cur); }
        if (!has_next) break;
#pragma unroll
        for (int a = 0; a < 2; ++a)
#pragma unroll
            for (int b = 0; b < 2; ++b)
#pragma unroll
                for (int m = 0; m < 4; ++m)
#pragma unroll
                    for (int n = 0; n < 2; ++n) acc[a][b][m][n] = (f32x4){0.f, 0.f, 0.f, 0.f};
        cur = nxt; cA = nA; cB = nB; ++ui;
        if constexpr (ALIGN_EPI) { if (wr == 1) PG8_BAR; }
    }
    PG8_WAIT_V(0);
    if constexpr (!ALIGN_EPI) { if (wr == 0) PG8_BAR; }
    PG8_BAR;
    if constexpr (Epi::AFTER_DRAIN) { E.fused(acc, cur, wr, wc, fr, fq, lds, wid, lane); S.done(cur); }
#undef PG8_SA
#undef PG8_SB
#undef PG8_STAGE
#undef PG8_LDA
#undef PG8_LDB
#undef PG8_MMA
#undef PG8_WAIT_V
#undef PG8_WAIT_L
#undef PG8_BAR
#undef PG8_SCHED
}
}

#ifndef PG8_SP2
#define PG8_SP2 true
#endif
#ifndef PG8_ALIGN
#define PG8_ALIGN true
#endif
#ifndef MK_PER_PHASE
#define MK_PER_PHASE 0
#endif

constexpr int S = 8192, D = 2048, FF = 5632, NL = 4, NWAVES = 8;
constexpr float EPS = 1e-6f;
constexpr float QSCALE = 0.07216878364870322f * 1.4426950408889634f;

constexpr size_t MiB = 1u << 20;
constexpr size_t WS_CTL = 0, CTL_ZERO_BYTES = 1 * MiB;
constexpr size_t WS_MOD = 256 * 1024  , WS_ROPE = 2 * MiB, WS_GATE = 4 * MiB, WS_NST = 5 * MiB, WS_EST = 8 * MiB;
constexpr size_t WS_FFN1 = 24 * MiB, WS_FFN2 = 200 * MiB, WS_CIN = 288 * MiB, WS_COUT = 336 * MiB, WS_DQKV = 352 * MiB, WS_UQ = 358 * MiB, WS_UK = 363 * MiB, WS_UV = 365 * MiB,
                 WS_WO = 367 * MiB, WS_LIN = 375 * MiB, WS_LOUT = 399 * MiB;
constexpr size_t WS_H = 408 * MiB, WS_ACT = 440 * MiB, WS_MIX = 528 * MiB;
constexpr size_t WS_BG = WS_MIX, WS_CU = WS_MIX + 32 * MiB, WS_BZ = WS_MIX + 64 * MiB;
constexpr size_t WS_KVQ = WS_MIX, WS_CQN = WS_MIX + 48 * MiB, WS_CKVN = WS_MIX + 60 * MiB, WS_Q = WS_MIX + 68 * MiB, WS_K = WS_MIX + 116 * MiB, WS_VT = WS_MIX + 164 * MiB, WS_O = WS_MIX + 196 * MiB;
constexpr size_t WS_LQ = WS_MIX, WS_LK = WS_MIX + 16 * MiB, WS_LV = WS_MIX + 32 * MiB, WS_LOG = WS_MIX + 64 * MiB, WS_LH = WS_MIX + 96 * MiB, WS_LA = WS_MIX + 160 * MiB;
constexpr size_t WS_END = WS_MIX + 228 * MiB;
constexpr int CW_TMO = 0, CW_BAR = 4096;

constexpr int RING_BYTES = 131072, LDSCTL_OFF = RING_BYTES, MISC_OFF = LDSCTL_OFF + 320, LDS_BYTES = 147456;

#define GAS __attribute__((address_space(1)))
#define LAS __attribute__((address_space(3)))
typedef unsigned short bf16;
typedef unsigned v4u __attribute__((ext_vector_type(4)));
typedef unsigned v2u __attribute__((ext_vector_type(2)));
typedef float f32x4 __attribute__((ext_vector_type(4)));
typedef GAS unsigned gu32;
#define RLX_AGENT __ATOMIC_RELAXED, __HIP_MEMORY_SCOPE_AGENT
using pg8::pk2;
using pg8::u32x2;
#define XB_TMO      128
#define XB_XCNT(j)  (256  + 64 * (j))
#define XB_XSUB(j)  (1280 + 64 * (j))
#define XB_XGEN(j)  (2304 + 64 * (j))
#define XB_TOP      3328
#define XB_TOPGEN   3392
#define XCD_BAR_WORDS 3456
#define XB_SPIN_CAP (1u << 18)

__device__ __forceinline__ unsigned xb_ld(unsigned* p)              { return __hip_atomic_load(p, __ATOMIC_RELAXED, __HIP_MEMORY_SCOPE_AGENT); }
__device__ __forceinline__ unsigned xb_add(unsigned* p, unsigned v) { return __hip_atomic_fetch_add(p, v, __ATOMIC_RELAXED, __HIP_MEMORY_SCOPE_AGENT); }
__device__ __forceinline__ unsigned xb_xcc_id() { return (unsigned)__builtin_amdgcn_s_getreg((3 << 11) | 20) & 0xFu; }
#define XB_SPIN(cond, bar) do { unsigned _sp = 0; while (cond) { __builtin_amdgcn_s_sleep(1); \
    if ((++_sp & 255u) == 0u) { if (xb_ld(&(bar)[XB_TMO])) break; if (_sp > XB_SPIN_CAP) { atomicAdd(&(bar)[XB_TMO], 1u); break; } } } } while (0)

struct XcdBarrier {
    unsigned* bar; unsigned x;
    volatile LAS unsigned* st;
};

__device__ __forceinline__ XcdBarrier xcd_barrier_post(unsigned* bar, volatile LAS unsigned* st) {
    XcdBarrier b; b.bar = bar; b.x = xb_xcc_id(); b.st = st;
    if (threadIdx.x == 0) (void)xb_add(&bar[XB_XCNT(b.x)], 1u);
    return b;
}
__device__ __forceinline__ void xcd_barrier_complete(unsigned* bar, unsigned x, unsigned& nloc, unsigned& nx) {
    const unsigned G = gridDim.x * gridDim.y * gridDim.z;
    unsigned sum, cnt, mine, sp = 0u;
    for (;;) {
        sum = 0u; cnt = 0u; mine = 0u;
#pragma unroll
        for (unsigned j = 0; j < 16; ++j) { const unsigned c = xb_ld(&bar[XB_XCNT(j)]); sum += c; cnt += (c > 0u) ? 1u : 0u; mine = (j == x) ? c : mine; }
        if (sum == G) break;
        __builtin_amdgcn_s_sleep(1);
        if ((++sp & 255u) == 0u) { if (xb_ld(&bar[XB_TMO])) break; if (sp > XB_SPIN_CAP) { atomicAdd(&bar[XB_TMO], 1u); break; } }
    }
    nloc = mine > 0u ? mine : 1u; nx = cnt > 0u ? cnt : 1u;
}

__device__ __forceinline__ void xcd_barrier(const XcdBarrier& b) {
    asm volatile("s_waitcnt vmcnt(0)" ::: "memory");
    __syncthreads();
    if (threadIdx.x == 0) {
        unsigned* bar = b.bar;
        __builtin_amdgcn_s_waitcnt(0);
        unsigned nloc = b.st[0], nx = b.st[1];
        if (nloc == 0u) { xcd_barrier_complete(bar, b.x, nloc, nx); b.st[0] = nloc; b.st[1] = nx; }
        const unsigned old = xb_add(&bar[XB_XSUB(b.x)], 1u);
        const unsigned gen = old / nloc;
        if (old + 1u == (gen + 1u) * nloc) {
            __builtin_amdgcn_fence(__ATOMIC_RELEASE, "agent");
            asm volatile("s_waitcnt vmcnt(0)" ::: "memory");
            const unsigned og = xb_add(&bar[XB_TOP], 1u);
            const unsigned tg = og / nx;
            if (og + 1u == (tg + 1u) * nx) xb_add(&bar[XB_TOPGEN], 1u);
            else XB_SPIN(xb_ld(&bar[XB_TOPGEN]) == tg, bar);
            __builtin_amdgcn_fence(__ATOMIC_ACQUIRE, "agent");
            xb_add(&bar[XB_XGEN(b.x)], 1u);
            asm volatile("s_waitcnt vmcnt(0)" ::: "memory");
        } else {
            XB_SPIN(xb_ld(&bar[XB_XGEN(b.x)]) == gen, bar);
            __builtin_amdgcn_fence(__ATOMIC_ACQUIRE, "agent");
            asm volatile("s_waitcnt vmcnt(0)" ::: "memory");
        }
    }
    __syncthreads();
}


namespace attn {
typedef short bf16x8 __attribute__((ext_vector_type(8)));
typedef float f32x16 __attribute__((ext_vector_type(16)));
typedef unsigned u32x4 __attribute__((ext_vector_type(4)));
typedef unsigned u32x2 __attribute__((ext_vector_type(2)));
constexpr int S_ = 8192, NH = 16, DQK = 192, DV = 128, LDQ = NH * DQK  , LDO = NH * DV  ;
constexpr int KT_BYTES = 64 * DQK * 2  , VT_BYTES = DV * 64 * 2  , BUF_BYTES = KT_BYTES + VT_BYTES  ;
constexpr int LDS_BYTES = 2 * BUF_BYTES;

#define ATT_MFMA(a, b, c) __builtin_amdgcn_mfma_f32_32x32x16_bf16((a), (b), (c), 0, 0, 0)

__device__ __forceinline__ void attn_block(LAS unsigned char* lds, const bf16* __restrict__ Q, const bf16* __restrict__ K, const bf16* __restrict__ Vt, bf16* __restrict__ O,
                                           int head, int qb, int tid, int wave, int lane) {
    const int r = lane & 31, h = lane >> 5, x = (r >> 1) & 7;
    const int q0 = qb * 256 + wave * 32;
    const int ntiles = 4 * (qb + 1);
    unsigned ksrc[3], vsrc[2];
#pragma unroll
    for (int i = 0; i < 3; ++i) { const int p = i * 512 + tid, key = p / 24, cp = p % 24, c = (cp & ~7) | ((cp ^ (key >> 1)) & 7); ksrc[i] = (unsigned)(key * (LDQ * 2) + head * (DQK * 2) + c * 16); }
#pragma unroll
    for (int i = 0; i < 2; ++i) { const int p = i * 512 + tid, d = p >> 3, cp = p & 7, c = cp ^ ((d >> 1) & 7); vsrc[i] = (unsigned)((head * DV + d) * (S_ * 2) + c * 16); }
    unsigned koff[4], voff[4];
#pragma unroll
    for (int i = 0; i < 4; ++i) { koff[i] = (unsigned)(r * 384 + (((2 * i + h) ^ x) * 16)); voff[i] = (unsigned)(KT_BYTES + r * 128 + (((2 * i + h) ^ x) * 16)); }
    bf16x8 qf[12];
    { const bf16* qp = Q + (size_t)(q0 + r) * LDQ + head * DQK + 8 * h;
#pragma unroll
      for (int s = 0; s < 12; ++s) qf[s] = *(const bf16x8*)(qp + 16 * s); }
    f32x16 o[4];
#pragma unroll
    for (int d = 0; d < 4; ++d)
#pragma unroll
        for (int i = 0; i < 16; ++i) o[d][i] = 0.f;
    float m_run = -1e30f, l_run = 0.f;
    const char* kg = (const char*)K; const char* vg = (const char*)Vt;
    const unsigned ldsw = (unsigned)wave * 1024u;
#define ATT_STAGE(buf, t) do { const char* kt_ = kg + (size_t)(t) * (64 * LDQ * 2); const char* vt_ = vg + (size_t)(t) * 128; \
        _Pragma("unroll") for (int i_ = 0; i_ < 3; ++i_) __builtin_amdgcn_global_load_lds((const unsigned*)(kt_ + ksrc[i_]), (LAS unsigned*)(lds + (buf) * BUF_BYTES + i_ * 8192 + ldsw), 16, 0, 0); \
        _Pragma("unroll") for (int i_ = 0; i_ < 2; ++i_) __builtin_amdgcn_global_load_lds((const unsigned*)(vt_ + vsrc[i_]), (LAS unsigned*)(lds + (buf) * BUF_BYTES + KT_BYTES + i_ * 8192 + ldsw), 16, 0, 0); } while (0)
    __builtin_amdgcn_s_barrier();
    ATT_STAGE(0, 0);
    for (int t = 0; t < ntiles; ++t) {
        asm volatile("s_waitcnt vmcnt(0)" ::: "memory");
        __builtin_amdgcn_s_barrier();
        asm volatile("" ::: "memory");
        if (t + 1 < ntiles) { if ((t + 1) & 1) ATT_STAGE(1, t + 1); else ATT_STAGE(0, t + 1); }
        const int key0 = t * 64;
        if (key0 <= q0 + 31) {
            LAS unsigned char* kb_ = lds + (t & 1) * BUF_BYTES;
            f32x16 sc[2];
#pragma unroll
            for (int i = 0; i < 16; ++i) { sc[0][i] = 0.f; sc[1][i] = 0.f; }
#pragma unroll
            for (int s = 0; s < 12; ++s) {
#pragma unroll
                for (int kb = 0; kb < 2; ++kb) {
                    const bf16x8 kf = *(const LAS bf16x8*)(kb_ + koff[s & 3] + (s >> 2) * 128 + kb * (32 * 384));
                    sc[kb] = ATT_MFMA(kf, qf[s], sc[kb]);
                }
            }
            if (key0 + 63 > q0) {
                const int qrow = q0 + r;
#pragma unroll
                for (int kb = 0; kb < 2; ++kb)
#pragma unroll
                    for (int i = 0; i < 16; ++i) { const int key = key0 + 32 * kb + (i & 3) + 8 * (i >> 2) + 4 * h; sc[kb][i] = key > qrow ? -__builtin_inff() : sc[kb][i]; }
            }
            float mx = sc[0][0];
#pragma unroll
            for (int i = 1; i < 16; ++i) mx = fmaxf(mx, sc[0][i]);
#pragma unroll
            for (int i = 0; i < 16; ++i) mx = fmaxf(mx, sc[1][i]);
            mx = fmaxf(mx, __shfl_xor(mx, 32));
            const float m_new = fmaxf(m_run, mx);
            const float alpha = __builtin_amdgcn_exp2f(m_run - m_new);
            m_run = m_new;
            float ps = 0.f;
#pragma unroll
            for (int kb = 0; kb < 2; ++kb)
#pragma unroll
                for (int i = 0; i < 16; ++i) { const float p = __builtin_amdgcn_exp2f(sc[kb][i] - m_new); sc[kb][i] = p; ps += p; }
            l_run = l_run * alpha + ps;
#pragma unroll
            for (int d = 0; d < 4; ++d)
#pragma unroll
                for (int i = 0; i < 16; ++i) o[d][i] *= alpha;
            bf16x8 pf[4];
#pragma unroll
            for (int s = 0; s < 4; ++s) { u32x4 w;
                const int b = (s & 1) * 8;
                w.x = pg8::pk2(sc[s >> 1][b + 0], sc[s >> 1][b + 1]); w.y = pg8::pk2(sc[s >> 1][b + 2], sc[s >> 1][b + 3]);
                w.z = pg8::pk2(sc[s >> 1][b + 4], sc[s >> 1][b + 5]); w.w = pg8::pk2(sc[s >> 1][b + 6], sc[s >> 1][b + 7]);
                pf[s] = __builtin_bit_cast(bf16x8, w); }
#pragma unroll
            for (int d = 0; d < 4; ++d)
#pragma unroll
                for (int s = 0; s < 4; ++s) {
                    const bf16x8 vf = *(const LAS bf16x8*)(kb_ + voff[s] + d * (32 * 128));
                    o[d] = ATT_MFMA(vf, pf[s], o[d]);
                }
        }
    }
    const float l_tot = l_run + __shfl_xor(l_run, 32);
    const float inv = 1.0f / l_tot;
    bf16* op = O + (size_t)(q0 + r) * LDO + head * DV + 4 * h;
#pragma unroll
    for (int d = 0; d < 4; ++d)
#pragma unroll
        for (int g = 0; g < 4; ++g) { u32x2 w; w.x = pg8::pk2(o[d][4 * g] * inv, o[d][4 * g + 1] * inv); w.y = pg8::pk2(o[d][4 * g + 2] * inv, o[d][4 * g + 3] * inv);
            *(u32x2*)(op + 32 * d + 8 * g) = w; }
#undef ATT_STAGE
}

__device__ __forceinline__ void attn_phase(LAS unsigned char* lds, const bf16* Q, const bf16* K, const bf16* Vt, bf16* O, int G, int c, int tid, int wave, int lane) {
    for (int unit = c; unit < 256; unit += G) {
        const int head = (unit & 7) * 2 + ((unit >> 3) & 1), pair = unit >> 4;
        attn_block(lds, Q, K, Vt, O, head, pair, tid, wave, lane);
        attn_block(lds, Q, K, Vt, O, head, 31 - pair, tid, wave, lane);
    }
    asm volatile("s_waitcnt vmcnt(0)" ::: "memory");
    __builtin_amdgcn_s_barrier();
}
#undef ATT_MFMA
}

namespace mlstm {
typedef short bf16x8 __attribute__((ext_vector_type(8)));
typedef float f32x4 __attribute__((ext_vector_type(4)));
typedef unsigned u32x4 __attribute__((ext_vector_type(4)));
constexpr int S_ = 8192, NHD = 4, DK = 256, DVH = 512, DVS = 64, NSEG = 8, CPS = 16;
constexpr int OFF_QS = 0, OFF_KS = 32768, OFF_CT = 65536, OFF_VT = 98304, OFF_SW = 106496, OFF_VA = 114688, OFF_VM = OFF_VA + 4096, OFF_VF = OFF_VM + 4096,
              OFF_AMAX = OFF_VF + 4096, OFF_F63 = OFF_AMAX + 512, OFF_MST = OFF_F63 + 512, OFF_N = OFF_MST + 512, OFF_DEN = OFF_N + 1024, OFF_QN = OFF_DEN + 512, LDS_END = OFF_QN + 256;
static_assert(LDS_END <= 131072, "mlstm LDS map");
#define ML_MFMA(a, b, c) __builtin_amdgcn_mfma_f32_16x16x32_bf16((a), (b), (c), 0, 0, 0)
__device__ __forceinline__ float fexp(float x) { return __builtin_amdgcn_exp2f(x * 1.4426950408889634f); }
__device__ __forceinline__ float wave_incl_sum(float v, int lane) {
#pragma unroll
    for (int o = 1; o < 64; o <<= 1) { const float t = __shfl_up(v, o); if (lane >= o) v += t; }
    return v; }
__device__ __forceinline__ float wave_incl_max(float v, int lane) {
#pragma unroll
    for (int o = 1; o < 64; o <<= 1) { const float t = __shfl_up(v, o); if (lane >= o) v = fmaxf(v, t); }
    return v; }
__device__ __forceinline__ float bflo(unsigned w) { return __uint_as_float(w << 16); }
__device__ __forceinline__ float bfhi(unsigned w) { return __uint_as_float(w & 0xffff0000u); }
__device__ __forceinline__ float bfel(const u32x4& v, int e) { const unsigned w = v[e >> 1]; return (e & 1) ? bfhi(w) : bflo(w); }
__device__ __forceinline__ int sw512(int row, int c) { return row * 512 + (((c & 16) | ((c ^ row) & 15)) << 4); }
__device__ __forceinline__ int sw128(int row, int c) { return row * 128 + ((c ^ ((row >> 1) & 7)) << 4); }

template <int PASS>
__device__ __forceinline__ void seg_pass(LAS unsigned char* lds, const bf16* __restrict__ Qg, const bf16* __restrict__ Kg, const bf16* __restrict__ Vg,
                                         const float* __restrict__ ipre, const float* __restrict__ logf, float* __restrict__ Est, float* __restrict__ Nst, float* __restrict__ hout,
                                         int unit, int tid, int wave, int lane) {
    const int xcd = unit & 7, jj = unit >> 3, ds = jj & 7, idx = xcd * 4 + (jj >> 3), hd = idx >> 3, sg = idx & 7;
    const int l15 = lane & 15, kq = lane >> 4;
    LAS float* VA = (LAS float*)(lds + OFF_VA); LAS float* VM = (LAS float*)(lds + OFF_VM); LAS float* VF = (LAS float*)(lds + OFF_VF);
    LAS float* AMAX = (LAS float*)(lds + OFF_AMAX); LAS float* F63 = (LAS float*)(lds + OFF_F63); LAS float* MST = (LAS float*)(lds + OFF_MST);
    LAS float* NS = (LAS float*)(lds + OFF_N); LAS float* DEN = (LAS float*)(lds + OFF_DEN); LAS float* QN = (LAS float*)(lds + OFF_QN);
    const float* ip_h = ipre + (size_t)hd * S_; const float* lf_h = logf + (size_t)hd * S_;
    for (int c = wave; c < 128; c += 8) {
        const float lf = lf_h[c * 64 + lane], ip = ip_h[c * 64 + lane];
        const float fc = wave_incl_sum(lf, lane), a = ip - fc, am = wave_incl_max(a, lane);
        if (lane == 63) { F63[c] = fc; AMAX[c] = am; }
    }
    __syncthreads();
    if (tid == 0) { float m = 0.f; for (int c = 0; c < 128; ++c) { MST[c] = m; m = F63[c] + fmaxf(m, AMAX[c]); } }
    __syncthreads();
#pragma unroll
    for (int t = 0; t < 2; ++t) { const int cc = wave * 2 + t, c = sg * CPS + cc;
        const float lf = lf_h[c * 64 + lane], ip = ip_h[c * 64 + lane];
        const float fc = wave_incl_sum(lf, lane), a = ip - fc, pm = wave_incl_max(a, lane);
        VA[cc * 64 + lane] = a; VM[cc * 64 + lane] = fmaxf(MST[c], pm); VF[cc * 64 + lane] = fc; }
    f32x4 C[2][4];
#pragma unroll
    for (int a = 0; a < 2; ++a)
#pragma unroll
        for (int b = 0; b < 4; ++b) C[a][b] = (f32x4){0.f, 0.f, 0.f, 0.f};
    float nreg = 0.f;
    if (PASS == 2) {
        for (int sp = 0; sp < sg; ++sp) {
            float ld = 0.f;
            for (int c = sp * CPS; c < (sp + 1) * CPS; ++c) ld += MST[c] - fmaxf(MST[c], AMAX[c]);
            const float D = fexp(ld);
            const float* e = Est + ((((size_t)(hd * NSEG + sp) * 8 + ds) * 8 + wave) * 64 + lane) * 32;
#pragma unroll
            for (int a = 0; a < 2; ++a)
#pragma unroll
                for (int b = 0; b < 4; ++b) { const f32x4 ev = *(const f32x4*)(e + (a * 4 + b) * 4); C[a][b] = C[a][b] * D + ev; }
            if (tid < 256) nreg = nreg * D + Nst[(size_t)(hd * NSEG + sp) * 256 + tid];
        }
    }
    if (tid < 256) NS[tid] = nreg;
    __syncthreads();
    const bf16* qb = Qg + hd * DK; const bf16* kb = Kg + hd * DK; const bf16* vb = Vg + hd * DVH + ds * DVS;
    const int jt = wave >> 1, t0 = 2 * (wave & 1);
    for (int cc = 0; cc < CPS; ++cc) {
        const int c = sg * CPS + cc, pos0 = c * 64;
        const float mst = MST[c], M63 = VM[cc * 64 + 63], decay = fexp(mst - M63);
        u32x4 kreg[2][2], vreg[2], qreg[4];
#pragma unroll
        for (int i = 0; i < 2; ++i) { const int qd = i * 512 + tid, sp = qd >> 5, cch = qd & 31;
            kreg[i][0] = *(const u32x4*)(kb + (size_t)(pos0 + 2 * sp) * 1024 + 8 * cch); kreg[i][1] = *(const u32x4*)(kb + (size_t)(pos0 + 2 * sp + 1) * 1024 + 8 * cch); }
        if (tid < 256) { const int sp = tid >> 3, cch = tid & 7;
            vreg[0] = *(const u32x4*)(vb + (size_t)(pos0 + 2 * sp) * 2048 + 8 * cch); vreg[1] = *(const u32x4*)(vb + (size_t)(pos0 + 2 * sp + 1) * 2048 + 8 * cch); }
        if (PASS == 2) {
#pragma unroll
            for (int i = 0; i < 4; ++i) { const int p = i * 512 + tid, j = p >> 5, cch = p & 31; qreg[i] = *(const u32x4*)(qb + (size_t)(pos0 + j) * 1024 + 8 * cch); }
        }
        __syncthreads();
        if (tid < 256) { const int sp = tid >> 3, cch = tid & 7, s0 = 2 * sp;
#pragma unroll
            for (int e = 0; e < 8; ++e) { const int dv = 8 * cch + e; const unsigned w0 = vreg[0][e >> 1], w1 = vreg[1][e >> 1];
                const unsigned pr = (e & 1) ? ((w0 >> 16) | (w1 & 0xffff0000u)) : ((w0 & 0xffffu) | (w1 << 16));
                *(LAS unsigned*)(lds + OFF_VT + sw128(dv, s0 >> 3) + (s0 & 7) * 2) = pr; } }
        if (PASS == 2) {
#pragma unroll
            for (int i = 0; i < 4; ++i) { const int p = i * 512 + tid, j = p >> 5, cch = p & 31; *(LAS u32x4*)(lds + OFF_QS + sw512(j, cch)) = qreg[i]; }
#pragma unroll
            for (int i = 0; i < 2; ++i) { const int qd = i * 512 + tid, sp = qd >> 5, cch = qd & 31;
                *(LAS u32x4*)(lds + OFF_KS + sw512(2 * sp, cch)) = kreg[i][0]; *(LAS u32x4*)(lds + OFF_KS + sw512(2 * sp + 1, cch)) = kreg[i][1]; }
#pragma unroll
            for (int a = 0; a < 2; ++a)
#pragma unroll
                for (int b = 0; b < 4; ++b) { const int dv = 16 * b + l15, chunk = 4 * wave + 2 * a + (kq >> 1);
                    u32x2 w; w.x = pg8::pk2(C[a][b][0], C[a][b][1]); w.y = pg8::pk2(C[a][b][2], C[a][b][3]);
                    *(LAS u32x2*)(lds + OFF_CT + sw512(dv, chunk) + (kq & 1) * 8) = w; }
        }
        __syncthreads();
        f32x4 qc0 = {0.f, 0.f, 0.f, 0.f}, qc1 = {0.f, 0.f, 0.f, 0.f};
        if (PASS == 2) {
            f32x4 s0 = {0.f, 0.f, 0.f, 0.f}, s1 = {0.f, 0.f, 0.f, 0.f};
            const int rq = 16 * jt + l15, r0 = 16 * t0 + l15, r1 = r0 + 16;
#pragma unroll
            for (int ks = 0; ks < 8; ++ks) { const int ch = 4 * ks + kq;
                const bf16x8 aq = *(const LAS bf16x8*)(lds + OFF_QS + sw512(rq, ch));
                const bf16x8 bk0 = *(const LAS bf16x8*)(lds + OFF_KS + sw512(r0, ch)), bk1 = *(const LAS bf16x8*)(lds + OFF_KS + sw512(r1, ch));
                const bf16x8 bc0 = *(const LAS bf16x8*)(lds + OFF_CT + sw512(r0, ch)), bc1 = *(const LAS bf16x8*)(lds + OFF_CT + sw512(r1, ch));
                s0 = ML_MFMA(aq, bk0, s0); s1 = ML_MFMA(aq, bk1, s1); qc0 = ML_MFMA(aq, bc0, qc0); qc1 = ML_MFMA(aq, bc1, qc1);
                if (ks & 1) asm volatile("" ::: "memory"); }
            const float a0 = VA[cc * 64 + r0], a1 = VA[cc * 64 + r1];
            float rp[4];
#pragma unroll
            for (int rg = 0; rg < 4; ++rg) { const int j = 16 * jt + 4 * kq + rg; const float Mj = VM[cc * 64 + j];
                const float w0 = (r0 <= j) ? fexp(a0 - Mj) : 0.f, w1 = (r1 <= j) ? fexp(a1 - Mj) : 0.f;
                const float v0 = s0[rg] * w0, v1 = s1[rg] * w1; rp[rg] = v0 + v1;
                *(LAS unsigned short*)(lds + OFF_SW + sw128(j, r0 >> 3) + (r0 & 7) * 2) = (unsigned short)(pg8::pk2(v0, 0.f) & 0xffffu);
                *(LAS unsigned short*)(lds + OFF_SW + sw128(j, r1 >> 3) + (r1 & 7) * 2) = (unsigned short)(pg8::pk2(v1, 0.f) & 0xffffu); }
#pragma unroll
            for (int rg = 0; rg < 4; ++rg) { float v = rp[rg]; v += __shfl_xor(v, 1); v += __shfl_xor(v, 2); v += __shfl_xor(v, 4); v += __shfl_xor(v, 8);
                if (l15 == 0) DEN[(16 * jt + 4 * kq + rg) * 2 + (wave & 1)] = v; }
            { const int j = tid >> 3, part = tid & 7; float acc = 0.f;
#pragma unroll
              for (int cq = 0; cq < 4; ++cq) { const u32x4 qv = *(const LAS u32x4*)(lds + OFF_QS + sw512(j, 4 * part + cq));
#pragma unroll
                  for (int e = 0; e < 8; ++e) acc += bfel(qv, e) * NS[32 * part + 8 * cq + e]; }
              acc += __shfl_xor(acc, 1); acc += __shfl_xor(acc, 2); acc += __shfl_xor(acc, 4);
              if (part == 0) QN[j] = acc; }
            __syncthreads();
        }
#pragma unroll
        for (int i = 0; i < 2; ++i) { const int qd = i * 512 + tid, sp = qd >> 5, cch = qd & 31, s0i = 2 * sp;
            const float ws0 = fexp(VA[cc * 64 + s0i] - M63), ws1 = fexp(VA[cc * 64 + s0i + 1] - M63);
#pragma unroll
            for (int e = 0; e < 8; ++e) { const int dk = 8 * cch + e; const float k0 = bfel(kreg[i][0], e) * ws0, k1 = bfel(kreg[i][1], e) * ws1;
                *(LAS unsigned*)(lds + OFF_KS + sw128(dk, s0i >> 3) + (s0i & 7) * 2) = pg8::pk2(k0, k1); } }
        if (PASS == 2) {
            f32x4 n0 = {0.f, 0.f, 0.f, 0.f}, n1 = {0.f, 0.f, 0.f, 0.f};
            const int rq = 16 * jt + l15, r0 = 16 * t0 + l15, r1 = r0 + 16;
#pragma unroll
            for (int ks = 0; ks < 2; ++ks) { const int ch = 4 * ks + kq;
                const bf16x8 as = *(const LAS bf16x8*)(lds + OFF_SW + sw128(rq, ch));
                const bf16x8 bv0 = *(const LAS bf16x8*)(lds + OFF_VT + sw128(r0, ch)), bv1 = *(const LAS bf16x8*)(lds + OFF_VT + sw128(r1, ch));
                n0 = ML_MFMA(as, bv0, n0); n1 = ML_MFMA(as, bv1, n1); }
#pragma unroll
            for (int rg = 0; rg < 4; ++rg) { const int j = 16 * jt + 4 * kq + rg; const float Mj = VM[cc * 64 + j], fj = VF[cc * 64 + j];
                const float wi = fexp(mst - Mj), den = DEN[j * 2] + DEN[j * 2 + 1] + wi * QN[j];
                const float dd = fmaxf(fabsf(den), fexp(-(fj + Mj))), inv = 1.0f / dd;
                float* hp = hout + (size_t)(pos0 + j) * 2048 + hd * DVH + ds * DVS;
                hp[r0] = (n0[rg] + wi * qc0[rg]) * inv; hp[r1] = (n1[rg] + wi * qc1[rg]) * inv; }
        }
        __syncthreads();
#pragma unroll
        for (int a = 0; a < 2; ++a)
#pragma unroll
            for (int b = 0; b < 4; ++b) C[a][b] = C[a][b] * decay;
#pragma unroll
        for (int ks = 0; ks < 2; ++ks) { const int ch = 4 * ks + kq;
            bf16x8 bv[4];
#pragma unroll
            for (int b = 0; b < 4; ++b) bv[b] = *(const LAS bf16x8*)(lds + OFF_VT + sw128(16 * b + l15, ch));
#pragma unroll
            for (int a = 0; a < 2; ++a) { const bf16x8 ak = *(const LAS bf16x8*)(lds + OFF_KS + sw128(32 * wave + 16 * a + l15, ch));
#pragma unroll
                for (int b = 0; b < 4; ++b) C[a][b] = ML_MFMA(ak, bv[b], C[a][b]); } }
        if (tid < 256) { float acc = 0.f;
#pragma unroll
            for (int cq = 0; cq < 8; ++cq) { const u32x4 kv = *(const LAS u32x4*)(lds + OFF_KS + tid * 128 + cq * 16);
#pragma unroll
                for (int e = 0; e < 8; ++e) acc += bfel(kv, e); }
            nreg = nreg * decay + acc; NS[tid] = nreg; }
    }
    if (PASS == 1) {
        float* e = Est + ((((size_t)(hd * NSEG + sg) * 8 + ds) * 8 + wave) * 64 + lane) * 32;
#pragma unroll
        for (int a = 0; a < 2; ++a)
#pragma unroll
            for (int b = 0; b < 4; ++b) *(f32x4*)(e + (a * 4 + b) * 4) = C[a][b];
        if (ds == 0 && tid < 256) Nst[(size_t)(hd * NSEG + sg) * 256 + tid] = nreg;
    }
    __syncthreads();
}
#undef ML_MFMA
}

__device__ __forceinline__ float wave_sum(float v) {
#pragma unroll
    for (int o = 1; o < 64; o <<= 1) v += __shfl_xor(v, o);
    return v;
}
__device__ __forceinline__ float bf_lo(unsigned w) { return __uint_as_float(w << 16); }
__device__ __forceinline__ float bf_hi(unsigned w) { return __uint_as_float(w & 0xffff0000u); }

template <bool GATES>
__device__ __forceinline__ void norm_phase(LAS unsigned char* lds, int gw, int ngw, int tid, int lane, const float* __restrict__ xin, const float* __restrict__ g,
                                           const float* __restrict__ sc, const float* __restrict__ sh, bf16* __restrict__ hout,
                                           const float* __restrict__ wlin, const float* __restrict__ bgate, float* __restrict__ ipre, float* __restrict__ logf) {
    LAS float* GE = (LAS float*)lds; LAS float* SH = GE + D; LAS float* WG = SH + D;
    for (int i = tid; i < D; i += NWAVES * 64) { GE[i] = g[i] * (1.0f + sc[i]); SH[i] = sh[i]; }
    if (GATES) { for (int i = tid; i < D * 8; i += NWAVES * 64) WG[i] = wlin[(size_t)(i >> 3) * 6152 + 6144 + (i & 7)]; }
    __syncthreads();
    for (int m = gw; m < S; m += ngw) {
        const GAS f32x4* xr = (const GAS f32x4*)(xin + (size_t)m * D) + lane;
        f32x4 v[8]; float ss = 0.f;
#pragma unroll
        for (int j = 0; j < 8; ++j) { v[j] = xr[64 * j]; ss += (v[j].x * v[j].x + v[j].y * v[j].y) + (v[j].z * v[j].z + v[j].w * v[j].w); }
        const float rstd = 1.0f / sqrtf(wave_sum(ss) * (1.0f / D) + EPS);
        GAS v2u* o8 = (GAS v2u*)(hout + (size_t)m * D) + lane;
        float ga[8];
        if (GATES) {
#pragma unroll
            for (int q = 0; q < 8; ++q) ga[q] = 0.f; }
#pragma unroll
        for (int j = 0; j < 8; ++j) { const int col = 4 * lane + 256 * j; const f32x4 ge = *(const LAS f32x4*)(GE + col), sv = *(const LAS f32x4*)(SH + col);
            const f32x4 hv = v[j] * rstd * ge + sv; v2u w; w.x = pk2(hv.x, hv.y); w.y = pk2(hv.z, hv.w); o8[64 * j] = w;
            if (GATES) {
#pragma unroll
                for (int e = 0; e < 4; ++e) { const f32x4 w0 = *(const LAS f32x4*)(WG + (col + e) * 8), w1 = *(const LAS f32x4*)(WG + (col + e) * 8 + 4); const float he = hv[e];
                    ga[0] += he * w0.x; ga[1] += he * w0.y; ga[2] += he * w0.z; ga[3] += he * w0.w; ga[4] += he * w1.x; ga[5] += he * w1.y; ga[6] += he * w1.z; ga[7] += he * w1.w; }
                asm volatile("" ::: "memory"); } }
        if (GATES) {
#pragma unroll
            for (int q = 0; q < 8; ++q) ga[q] = wave_sum(ga[q]);
            float mine = ga[0];
#pragma unroll
            for (int q = 1; q < 8; ++q) mine = (lane == q) ? ga[q] : mine;
            if (lane < 8) { float gv = mine + bgate[lane]; gv = 15.0f * tanhf(gv * (1.0f / 15.0f));
                if (lane < 4) ipre[(size_t)lane * S + m] = gv;
                else { const float ls = fminf(gv, 0.f) - log1pf(expf(-fabsf(gv))); logf[(size_t)(lane - 4) * S + m] = ls; } } }
    }
}
__device__ __forceinline__ void conv_phase(int gw, int ngw, int lane, const bf16* __restrict__ BG, const bf16* __restrict__ CU, const float* __restrict__ cw, bf16* __restrict__ BZ) {
    for (int m = gw; m < S; m += ngw) {
#pragma unroll
        for (int j = 0; j < 4; ++j) { const int col = 8 * lane + 512 * j;
            const v4u b = *(const GAS v4u*)(BG + (size_t)m * D + col), c2 = *(const GAS v4u*)(CU + (size_t)m * D + col);
            v4u c1 = {0u, 0u, 0u, 0u}, c0 = {0u, 0u, 0u, 0u};
            if (m >= 1) c1 = *(const GAS v4u*)(CU + (size_t)(m - 1) * D + col);
            if (m >= 2) c0 = *(const GAS v4u*)(CU + (size_t)(m - 2) * D + col);
            float w0[8], w1[8], w2[8];
#pragma unroll
            for (int q = 0; q < 2; ++q) { const f32x4 a0 = *(const GAS f32x4*)(cw + col + 4 * q), a1 = *(const GAS f32x4*)(cw + D + col + 4 * q), a2 = *(const GAS f32x4*)(cw + 2 * D + col + 4 * q);
#pragma unroll
                for (int e = 0; e < 4; ++e) { w0[4 * q + e] = a0[e]; w1[4 * q + e] = a1[e]; w2[4 * q + e] = a2[e]; } }
            v4u o;
#pragma unroll
            for (int q = 0; q < 4; ++q) {
                const float z0 = w0[2 * q] * bf_lo(c0[q]) + w1[2 * q] * bf_lo(c1[q]) + w2[2 * q] * bf_lo(c2[q]);
                const float z1 = w0[2 * q + 1] * bf_hi(c0[q]) + w1[2 * q + 1] * bf_hi(c1[q]) + w2[2 * q + 1] * bf_hi(c2[q]);
                o[q] = pk2(bf_lo(b[q]) * z0, bf_hi(b[q]) * z1); }
            *(GAS v4u*)(BZ + (size_t)m * D + col) = o; }
    }
}
__device__ __forceinline__ void mla2_phase(int gw, int ngw, int lane, const float* __restrict__ KVQ, const float* __restrict__ gq, const float* __restrict__ gkv,
                                           const float* __restrict__ cs, const float* __restrict__ sn, bf16* __restrict__ CQN, bf16* __restrict__ CKVN, bf16* __restrict__ Kc) {
    for (int m = gw; m < S; m += ngw) {
        const float* row = KVQ + (size_t)m * 1536;
        f32x4 q[3], kv[2]; float sq = 0.f, sk = 0.f;
#pragma unroll
        for (int j = 0; j < 3; ++j) { q[j] = *(const GAS f32x4*)(row + 4 * lane + 256 * j); sq += (q[j].x * q[j].x + q[j].y * q[j].y) + (q[j].z * q[j].z + q[j].w * q[j].w); }
#pragma unroll
        for (int j = 0; j < 2; ++j) { kv[j] = *(const GAS f32x4*)(row + 768 + 4 * lane + 256 * j); sk += (kv[j].x * kv[j].x + kv[j].y * kv[j].y) + (kv[j].z * kv[j].z + kv[j].w * kv[j].w); }
        const float rq = 1.0f / sqrtf(wave_sum(sq) * (1.0f / 768.0f) + EPS), rk = 1.0f / sqrtf(wave_sum(sk) * (1.0f / 512.0f) + EPS);
#pragma unroll
        for (int j = 0; j < 3; ++j) { const f32x4 gg = *(const GAS f32x4*)(gq + 4 * lane + 256 * j); const f32x4 o = q[j] * rq * gg; v2u w; w.x = pk2(o.x, o.y); w.y = pk2(o.z, o.w);
            *(GAS v2u*)(CQN + (size_t)m * 768 + 4 * lane + 256 * j) = w; }
#pragma unroll
        for (int j = 0; j < 2; ++j) { const f32x4 gg = *(const GAS f32x4*)(gkv + 4 * lane + 256 * j); const f32x4 o = kv[j] * rk * gg; v2u w; w.x = pk2(o.x, o.y); w.y = pk2(o.z, o.w);
            *(GAS v2u*)(CKVN + (size_t)m * 512 + 4 * lane + 256 * j) = w; }
        const int i = lane & 31; const float x1 = row[1280 + i], x2 = row[1280 + 32 + i], c = cs[(size_t)m * 32 + i], s = sn[(size_t)m * 32 + i];
        const float y1 = x1 * c - x2 * s, y2 = x1 * s + x2 * c;
        const int a = lane & 7;
        const float p0 = __shfl(y1, 4 * a), p1 = __shfl(y1, 4 * a + 1), p2 = __shfl(y1, 4 * a + 2), p3 = __shfl(y1, 4 * a + 3);
        const float r0 = __shfl(y2, 4 * a), r1 = __shfl(y2, 4 * a + 1), r2 = __shfl(y2, 4 * a + 2), r3 = __shfl(y2, 4 * a + 3);
        v4u w; w.x = pk2(p0, p1); w.y = pk2(p2, p3); w.z = pk2(r0, r1); w.w = pk2(r2, r3);
        const int hg = lane >> 3;
        *(GAS v4u*)(Kc + (size_t)m * 3072 + hg * 192 + 128 + 8 * a) = w;
        *(GAS v4u*)(Kc + (size_t)m * 3072 + (hg + 8) * 192 + 128 + 8 * a) = w;
    }
}
__device__ __forceinline__ void mlstm5_phase(int gw, int ngw, int lane, const float* __restrict__ HO, const bf16* __restrict__ OG, const float* __restrict__ gn, bf16* __restrict__ A) {
    for (int m = gw; m < S; m += ngw) {
        const GAS f32x4* hr = (const GAS f32x4*)(HO + (size_t)m * D) + lane;
        f32x4 v[8]; float ss[4];
#pragma unroll
        for (int j = 0; j < 8; ++j) v[j] = hr[64 * j];
#pragma unroll
        for (int hd = 0; hd < 4; ++hd) { const f32x4 a = v[2 * hd], b = v[2 * hd + 1];
            ss[hd] = wave_sum((a.x * a.x + a.y * a.y) + (a.z * a.z + a.w * a.w) + (b.x * b.x + b.y * b.y) + (b.z * b.z + b.w * b.w)); }
#pragma unroll
        for (int j = 0; j < 8; ++j) { const int col = 4 * lane + 256 * j; const float rstd = 1.0f / sqrtf(ss[j >> 1] * (1.0f / 512.0f) + EPS);
            const f32x4 gg = *(const GAS f32x4*)(gn + col); const v2u og = *(const GAS v2u*)(OG + (size_t)m * D + col);
            const f32x4 o = v[j] * rstd * gg; v2u w; w.x = pk2(o.x * bf_lo(og.x), o.y * bf_hi(og.x)); w.y = pk2(o.z * bf_lo(og.y), o.w * bf_hi(og.y));
            *(GAS v2u*)(A + (size_t)m * D + col) = w; }
    }
}
__device__ __forceinline__ void final_phase(int gw, int ngw, int lane, float* __restrict__ x, const float* __restrict__ g) {
    for (int m = gw; m < S; m += ngw) {
        GAS f32x4* xr = (GAS f32x4*)(x + (size_t)m * D) + lane;
        f32x4 v[8]; float ss = 0.f;
#pragma unroll
        for (int j = 0; j < 8; ++j) { v[j] = xr[64 * j]; ss += (v[j].x * v[j].x + v[j].y * v[j].y) + (v[j].z * v[j].z + v[j].w * v[j].w); }
        const float rstd = 1.0f / sqrtf(wave_sum(ss) * (1.0f / D) + EPS);
#pragma unroll
        for (int j = 0; j < 8; ++j) { const f32x4 gg = *(const GAS f32x4*)(g + 4 * lane + 256 * j); xr[64 * j] = v[j] * rstd * gg; }
    }
}

__device__ const float ROPE_INVF[32] = {1.000000000e+00f, 7.498942614e-01f, 5.623413324e-01f, 4.216965139e-01f, 3.162277639e-01f, 2.371373773e-01f, 1.778279394e-01f, 1.333521307e-01f,
    1.000000015e-01f, 7.498941571e-02f, 5.623413250e-02f, 4.216965288e-02f, 3.162277490e-02f, 2.371373773e-02f, 1.778279431e-02f, 1.333521493e-02f,
    9.999999776e-03f, 7.498941850e-03f, 5.623413250e-03f, 4.216964822e-03f, 3.162277630e-03f, 2.371373586e-03f, 1.778279431e-03f, 1.333521446e-03f,
    1.000000047e-03f, 7.498942432e-04f, 5.623413017e-04f, 4.216965172e-04f, 3.162277571e-04f, 2.371373703e-04f, 1.778279402e-04f, 1.333521504e-04f};
__device__ __forceinline__ void sincos_f64(double x, float& s, float& c) {
    const double k = __builtin_rint(x * 0.63661977236758134308);
    double r = __builtin_fma(-k, 1.57079632679489655800e+00, x); r = __builtin_fma(-k, 6.12323399573676603587e-17, r);
    const double r2 = r * r;
    double sp = -7.6471637318198164759e-13; sp = sp * r2 + 1.6059043836821614599e-10; sp = sp * r2 - 2.5052108385441718775e-08; sp = sp * r2 + 2.7557319223985890653e-06;
    sp = sp * r2 - 1.9841269841269841270e-04; sp = sp * r2 + 8.3333333333333333333e-03; sp = sp * r2 - 1.6666666666666666667e-01; sp = r + r * r2 * sp;
    double cp = 4.7794773323873852974e-14; cp = cp * r2 - 1.1470745597729724714e-11; cp = cp * r2 + 2.0876756987868098979e-09; cp = cp * r2 - 2.7557319223985890653e-07;
    cp = cp * r2 + 2.4801587301587301587e-05; cp = cp * r2 - 1.3888888888888888889e-03; cp = cp * r2 + 4.1666666666666666667e-02; cp = 1.0 - 0.5 * r2 + r2 * r2 * cp;
    const int q = ((int)k) & 3;
    const double sv = (q == 0) ? sp : (q == 1) ? cp : (q == 2) ? -sp : -cp;
    const double cv = (q == 0) ? cp : (q == 1) ? -sp : (q == 2) ? -cp : sp;
    s = (float)sv; c = (float)cv;
}

enum { WK_FFN1 = 0, WK_FFN2, WK_CIN, WK_COUT, WK_DQKV, WK_UQ, WK_UK, WK_UV, WK_WO, WK_LIN, WK_LOUT };
struct Inputs { const float* in[25]; };
template <int KIND> __device__ __forceinline__ const float* src_col(const Inputs& I, int idx, int n, int& ld) {
    if (KIND == WK_FFN1) { const int pn = n >> 8, bj = (n >> 7) & 1, f = 128 * pn + (n & 127); ld = FF; return I.in[bj ? 8 : 7] + (size_t)idx * D * FF + f; }
    if (KIND == WK_FFN2) { ld = D; return I.in[9] + (size_t)idx * FF * D + n; }
    if (KIND == WK_CIN) { ld = 3 * D; int col = n; if (n >= D) { const int t = n - D, pn = t >> 8, bj = (t >> 7) & 1; col = D + bj * D + 128 * pn + (t & 127); } return I.in[10] + (size_t)idx * D * 3 * D + col; }
    if (KIND == WK_COUT) { ld = D; return I.in[12] + (size_t)idx * D * D + n; }
    if (KIND == WK_DQKV) { if (n < 768) { ld = 768; return I.in[13] + n; } if (n < 1344) { ld = 576; return I.in[16] + (n - 768); } ld = 0; return nullptr; }
    if (KIND == WK_UQ) { ld = 3072; const int head = n / 192, w = n - head * 192; int col = n; if (w >= 128) { const int r = w - 128, a = r >> 3, nn = (r >> 2) & 1, b = r & 3; col = head * 192 + 128 + nn * 32 + 4 * a + b; } return I.in[15] + col; }
    if (KIND == WK_UK) { ld = 4096; return I.in[18] + (n >> 7) * 256 + (n & 127); }
    if (KIND == WK_UV) { ld = 4096; return I.in[18] + (n >> 7) * 256 + 128 + (n & 127); }
    if (KIND == WK_WO) { ld = D; return I.in[19] + n; }
    if (KIND == WK_LIN) { ld = 6152; return I.in[20] + n; }
    ld = D; return I.in[23] + n;
}
template <int KIND> __device__ __forceinline__ void xpose_matrix(const Inputs& I, int idx, bf16* __restrict__ WT, int K, int N, LAS unsigned char* tile, int gw, int ngw, int lane) {
    const int nblk = N / 64, nitems = (K / 64) * nblk, c4 = lane & 15, kq = lane >> 4;
    for (int it = gw; it < nitems; it += ngw) {
        const int kb = it / nblk, nb = it - kb * nblk, k0 = 64 * kb, n0 = 64 * nb;
        int ld; const float* cp = src_col<KIND>(I, idx, n0 + 4 * c4, ld);
        f32x4 v[16];
        if (cp) { const float* rp = cp + (size_t)(k0 + 16 * kq) * ld;
#pragma unroll
            for (int i = 0; i < 16; ++i) v[i] = *(const GAS f32x4*)(rp + (size_t)i * ld); }
        else {
#pragma unroll
            for (int i = 0; i < 16; ++i) v[i] = (f32x4){0.f, 0.f, 0.f, 0.f}; }
#pragma unroll
        for (int e = 0; e < 4; ++e) { const int n = 4 * c4 + e;
#pragma unroll
            for (int h = 0; h < 2; ++h) { v4u o; o.x = pk2(v[8 * h + 0][e], v[8 * h + 1][e]); o.y = pk2(v[8 * h + 2][e], v[8 * h + 3][e]); o.z = pk2(v[8 * h + 4][e], v[8 * h + 5][e]); o.w = pk2(v[8 * h + 6][e], v[8 * h + 7][e]);
                *(LAS v4u*)(tile + n * 128 + (((2 * kq + h) ^ ((n >> 2) & 7)) << 4)) = o; } }
        asm volatile("s_waitcnt lgkmcnt(0)" ::: "memory");
        const int c = lane & 7;
#pragma unroll
        for (int j = 0; j < 8; ++j) { const int n = (lane >> 3) + 8 * j; const v4u o = *(const LAS v4u*)(tile + n * 128 + ((c ^ ((n >> 2) & 7)) << 4));
            *(GAS v4u*)(WT + (size_t)(n0 + n) * K + k0 + 8 * c) = o; }
        asm volatile("s_waitcnt lgkmcnt(0)" ::: "memory");
    }
}
__device__ __forceinline__ void prologue(const Inputs& I, unsigned char* ws, LAS unsigned char* lds, int vcu, int G, int tid, int wave, int lane) {
    const int gw = vcu * NWAVES + wave, ngw = G * NWAVES;
    LAS float* CA = (LAS float*)(lds + 81920); LAS float* RED = (LAS float*)(lds + 90112);
    for (int i = tid; i < D; i += NWAVES * 64) { const float cv = I.in[1][i]; CA[i] = cv / (1.0f + expf(-cv)); }
    __syncthreads();
    float* MOD = (float*)(ws + WS_MOD);
    for (int task = vcu; task < NL * 48 * 4; task += G) {
        const int l = task / 192, r = task - l * 192, cb = r >> 2, kp = r & 3, kbase = kp * 512 + wave * 64;
        const float* wp = I.in[3] + ((size_t)l * D + kbase) * (6 * D) + 256 * cb + 4 * lane;
        f32x4 acc = {0.f, 0.f, 0.f, 0.f};
#pragma unroll 16
        for (int i = 0; i < 64; ++i) { const f32x4 w = *(const GAS f32x4*)(wp + (size_t)i * (6 * D)); acc += w * CA[kbase + i]; }
        *(LAS f32x4*)(RED + wave * 256 + 4 * lane) = acc;
        __syncthreads();
        if (tid < 256) { float v = 0.f;
#pragma unroll
            for (int w = 0; w < 8; ++w) v += RED[w * 256 + tid];
            if (kp == 0) v += I.in[4][(size_t)l * 6 * D + 256 * cb + tid];
            atomicAdd(MOD + (size_t)l * 6 * D + 256 * cb + tid, v); }
        __syncthreads();
    }
    { float* cs = (float*)(ws + WS_ROPE); float* sn = cs + S * 32; const int* pos = (const int*)I.in[2];
      for (int idx = (vcu * NWAVES * 64) + tid; idx < S * 32; idx += G * NWAVES * 64) { const int s = idx >> 5, i = idx & 31;
          const float ang = (float)pos[s] * ROPE_INVF[i]; float sv, cv; sincos_f64((double)ang, sv, cv);
          cs[idx] = cv; sn[idx] = sv; } }
    LAS unsigned char* tile = lds + wave * 8192;
    for (int l = 0; l < NL; ++l) xpose_matrix<WK_FFN1>(I, l, (bf16*)(ws + WS_FFN1 + (size_t)l * 44 * MiB), D, 2 * FF, tile, gw, ngw, lane);
    for (int l = 0; l < NL; ++l) xpose_matrix<WK_FFN2>(I, l, (bf16*)(ws + WS_FFN2 + (size_t)l * 22 * MiB), FF, D, tile, gw, ngw, lane);
    for (int j = 0; j < 2; ++j) xpose_matrix<WK_CIN>(I, j, (bf16*)(ws + WS_CIN + (size_t)j * 24 * MiB), D, 3 * D, tile, gw, ngw, lane);
    for (int j = 0; j < 2; ++j) xpose_matrix<WK_COUT>(I, j, (bf16*)(ws + WS_COUT + (size_t)j * 8 * MiB), D, D, tile, gw, ngw, lane);
    xpose_matrix<WK_DQKV>(I, 0, (bf16*)(ws + WS_DQKV), D, 1536, tile, gw, ngw, lane);
    xpose_matrix<WK_UQ>(I, 0, (bf16*)(ws + WS_UQ), 768, 3072, tile, gw, ngw, lane);
    xpose_matrix<WK_UK>(I, 0, (bf16*)(ws + WS_UK), 512, 2048, tile, gw, ngw, lane);
    xpose_matrix<WK_UV>(I, 0, (bf16*)(ws + WS_UV), 512, 2048, tile, gw, ngw, lane);
    xpose_matrix<WK_WO>(I, 0, (bf16*)(ws + WS_WO), D, D, tile, gw, ngw, lane);
    xpose_matrix<WK_LIN>(I, 0, (bf16*)(ws + WS_LIN), D, 3 * D, tile, gw, ngw, lane);
    xpose_matrix<WK_LOUT>(I, 0, (bf16*)(ws + WS_LOUT), D, D, tile, gw, ngw, lane);
}

#ifndef NO_ATTN
#define NO_ATTN 0
#endif
#ifndef NO_ML1
#define NO_ML1 0
#endif
#ifndef NO_ML2
#define NO_ML2 0
#endif
#ifndef NO_PRO
#define NO_PRO 0
#endif
#ifndef NO_NG
#define NO_NG 0
#endif
#ifndef DUP_PRO
#define DUP_PRO 0
#endif
#ifndef DUP_ATT
#define DUP_ATT 0
#endif
#ifndef DUP_FFN1
#define DUP_FFN1 0
#endif
#ifndef DUP_THIN
#define DUP_THIN 0
#endif
#ifndef DUP_ML
#define DUP_ML 0
#endif
#ifndef DUP_FFN2
#define DUP_FFN2 0
#endif
struct Args { Inputs I; float* out; unsigned char* ws; int ph_lo, ph_hi; };
constexpr int N_PHASES = 34;

template <class Epi> __device__ __forceinline__ void run_gemm(LAS unsigned char* lds, const bf16* A, const bf16* Bt, int M, int N, int K, int G, int c, const Epi& E) {
    pg8::Gemm g{A, Bt, M, N, K}; pg8::StaticOrder So; So.init(M, N, G, c);
    pg8::gemm_phase<Epi, pg8::StaticOrder, PG8_ALIGN, PG8_SP2>(lds, g, So, E);
}

__global__ void __launch_bounds__(NWAVES * 64, 2) trunk_fwd(Args args) {
    extern __shared__ __attribute__((aligned(16))) unsigned char lds_raw[];
    LAS unsigned char* lds = (LAS unsigned char*)lds_raw;
    volatile LAS unsigned* MISC = (volatile LAS unsigned*)(lds + MISC_OFF);
    const int tid = threadIdx.x, lane = tid & 63, wave = __builtin_amdgcn_readfirstlane(tid >> 6);
    const int G = gridDim.x, bx = blockIdx.x, vcu = (G % 8 == 0) ? (bx % 8) * (G / 8) + bx / 8 : bx;
    const int gw = vcu * NWAVES + wave, ngw = G * NWAVES;
    unsigned char* ws = args.ws; gu32* ctl = (gu32*)(ws + WS_CTL);
    for (int u = tid; u < (LDS_BYTES - LDSCTL_OFF) / 4; u += NWAVES * 64) ((LAS unsigned*)(lds + LDSCTL_OFF))[u] = 0u;
    __syncthreads();
    XcdBarrier bar; bar.bar = (unsigned*)(ctl + CW_BAR); bar.x = 0; bar.st = nullptr;
    if (!MK_PER_PHASE) bar = xcd_barrier_post((unsigned*)(ctl + CW_BAR), MISC + 8);
    const int lo = args.ph_lo, hi = args.ph_hi;
    int ph = 0;
#define PHASE_BEGIN if (lo <= ph && ph < hi) {
#define PHASE_END   if (!MK_PER_PHASE && ph + 1 < hi) xcd_barrier(bar); } ++ph;
    const Inputs& I = args.I;
    float* X = args.out;
    float* MOD = (float*)(ws + WS_MOD);
    const float* CS = (const float*)(ws + WS_ROPE); const float* SN = CS + S * 32;
    float* IPRE = (float*)(ws + WS_GATE); float* LOGF = IPRE + 4 * S;
    bf16* H = (bf16*)(ws + WS_H); bf16* ACT = (bf16*)(ws + WS_ACT);

    PHASE_BEGIN if (!NO_PRO) prologue(I, ws, lds, vcu, G, tid, wave, lane); if (DUP_PRO) { __syncthreads(); prologue(I, ws, lds, vcu, G, tid, wave, lane); } PHASE_END

#define MODV(l, k) (MOD + (size_t)(l) * 6 * D + (k) * D)
#define FFN_PHASES(l) \
    PHASE_BEGIN norm_phase<false>(lds, gw, ngw, tid, lane, X, I.in[6] + (l) * D, MODV(l, 4), MODV(l, 3), H, nullptr, nullptr, nullptr, nullptr); if (DUP_THIN) { __syncthreads(); norm_phase<false>(lds, gw, ngw, tid, lane, X, I.in[6] + (l) * D, MODV(l, 4), MODV(l, 3), H, nullptr, nullptr, nullptr, nullptr); } PHASE_END \
    PHASE_BEGIN { pg8::EpiSwiGLU E{ACT, FF}; run_gemm(lds, H, (const bf16*)(ws + WS_FFN1 + (size_t)(l) * 44 * MiB), S, 2 * FF, D, G, bx, E); if (DUP_FFN1) run_gemm(lds, H, (const bf16*)(ws + WS_FFN1 + (size_t)(l) * 44 * MiB), S, 2 * FF, D, G, bx, E); } PHASE_END \
    PHASE_BEGIN { if (DUP_FFN2) { pg8::EpiResid E2{X, (float*)(ws + WS_MIX), MODV(l, 5), D}; run_gemm(lds, ACT, (const bf16*)(ws + WS_FFN2 + (size_t)(l) * 22 * MiB), S, D, FF, G, bx, E2); } pg8::EpiResid E{X, X, MODV(l, 5), D}; run_gemm(lds, ACT, (const bf16*)(ws + WS_FFN2 + (size_t)(l) * 22 * MiB), S, D, FF, G, bx, E); } PHASE_END
#define CONV_PHASES(l, j, XIN) \
    PHASE_BEGIN norm_phase<false>(lds, gw, ngw, tid, lane, XIN, I.in[5] + (l) * D, MODV(l, 1), MODV(l, 0), H, nullptr, nullptr, nullptr, nullptr); if (DUP_THIN) { __syncthreads(); norm_phase<false>(lds, gw, ngw, tid, lane, XIN, I.in[5] + (l) * D, MODV(l, 1), MODV(l, 0), H, nullptr, nullptr, nullptr, nullptr); } PHASE_END \
    PHASE_BEGIN { pg8::EpiConvIn E{(bf16*)(ws + WS_BG), (bf16*)(ws + WS_CU), D}; run_gemm(lds, H, (const bf16*)(ws + WS_CIN + (size_t)(j) * 24 * MiB), S, 3 * D, D, G, bx, E); } PHASE_END \
    PHASE_BEGIN conv_phase(gw, ngw, lane, (const bf16*)(ws + WS_BG), (const bf16*)(ws + WS_CU), I.in[11] + (j) * 3 * D, (bf16*)(ws + WS_BZ)); if (DUP_THIN) { __syncthreads(); conv_phase(gw, ngw, lane, (const bf16*)(ws + WS_BG), (const bf16*)(ws + WS_CU), I.in[11] + (j) * 3 * D, (bf16*)(ws + WS_BZ)); } PHASE_END \
    PHASE_BEGIN { pg8::EpiResid E{XIN, X, MODV(l, 2), D}; run_gemm(lds, (const bf16*)(ws + WS_BZ), (const bf16*)(ws + WS_COUT + (size_t)(j) * 8 * MiB), S, D, D, G, bx, E); } PHASE_END

    CONV_PHASES(0, 0, I.in[0])
    FFN_PHASES(0)
    PHASE_BEGIN norm_phase<false>(lds, gw, ngw, tid, lane, X, I.in[5] + 1 * D, MODV(1, 1), MODV(1, 0), H, nullptr, nullptr, nullptr, nullptr); if (DUP_THIN) { __syncthreads(); norm_phase<false>(lds, gw, ngw, tid, lane, X, I.in[5] + 1 * D, MODV(1, 1), MODV(1, 0), H, nullptr, nullptr, nullptr, nullptr); } PHASE_END
    PHASE_BEGIN { pg8::EpiF32 E{(float*)(ws + WS_KVQ), 1536}; run_gemm(lds, H, (const bf16*)(ws + WS_DQKV), S, 1536, D, G, bx, E); } PHASE_END
    PHASE_BEGIN mla2_phase(gw, ngw, lane, (const float*)(ws + WS_KVQ), I.in[14], I.in[17], CS, SN, (bf16*)(ws + WS_CQN), (bf16*)(ws + WS_CKVN), (bf16*)(ws + WS_K)); if (DUP_THIN) { __syncthreads(); mla2_phase(gw, ngw, lane, (const float*)(ws + WS_KVQ), I.in[14], I.in[17], CS, SN, (bf16*)(ws + WS_CQN), (bf16*)(ws + WS_CKVN), (bf16*)(ws + WS_K)); } PHASE_END
    PHASE_BEGIN {
        { pg8::EpiQRope E{(bf16*)(ws + WS_Q), 3072, QSCALE, CS, SN}; run_gemm(lds, (const bf16*)(ws + WS_CQN), (const bf16*)(ws + WS_UQ), S, 3072, 768, G, bx, E); }
        { pg8::EpiKnope E{(bf16*)(ws + WS_K), 3072}; run_gemm(lds, (const bf16*)(ws + WS_CKVN), (const bf16*)(ws + WS_UK), S, 2048, 512, G, bx, E); }
        { pg8::EpiVt E{(bf16*)(ws + WS_VT), S}; run_gemm(lds, (const bf16*)(ws + WS_UV), (const bf16*)(ws + WS_CKVN), 2048, S, 512, G, bx, E); }
    } PHASE_END
    PHASE_BEGIN if (!NO_ATTN) attn::attn_phase(lds, (const bf16*)(ws + WS_Q), (const bf16*)(ws + WS_K), (const bf16*)(ws + WS_VT), (bf16*)(ws + WS_O), G, bx, tid, wave, lane); if (DUP_ATT) attn::attn_phase(lds, (const bf16*)(ws + WS_Q), (const bf16*)(ws + WS_K), (const bf16*)(ws + WS_VT), (bf16*)(ws + WS_O), G, bx, tid, wave, lane); PHASE_END
    PHASE_BEGIN { pg8::EpiResid E{X, X, MODV(1, 2), D}; run_gemm(lds, (const bf16*)(ws + WS_O), (const bf16*)(ws + WS_WO), S, D, D, G, bx, E); } PHASE_END
    FFN_PHASES(1)
    PHASE_BEGIN if (!NO_NG) norm_phase<true>(lds, gw, ngw, tid, lane, X, I.in[5] + 2 * D, MODV(2, 1), MODV(2, 0), H, I.in[20], I.in[21], IPRE, LOGF); PHASE_END
    PHASE_BEGIN { pg8::EpiMlstmIn E{(bf16*)(ws + WS_LQ), (bf16*)(ws + WS_LK), (bf16*)(ws + WS_LV), (bf16*)(ws + WS_LOG), 0.0625f}; run_gemm(lds, H, (const bf16*)(ws + WS_LIN), S, 3 * D, D, G, bx, E); } PHASE_END
    PHASE_BEGIN if (!NO_ML1) for (int u = bx; u < 256; u += G) mlstm::seg_pass<1>(lds, (const bf16*)(ws + WS_LQ), (const bf16*)(ws + WS_LK), (const bf16*)(ws + WS_LV), IPRE, LOGF, (float*)(ws + WS_EST), (float*)(ws + WS_NST), (float*)(ws + WS_LH), u, tid, wave, lane); if (DUP_ML) { if (!NO_ML1) for (int u = bx; u < 256; u += G) mlstm::seg_pass<1>(lds, (const bf16*)(ws + WS_LQ), (const bf16*)(ws + WS_LK), (const bf16*)(ws + WS_LV), IPRE, LOGF, (float*)(ws + WS_EST), (float*)(ws + WS_NST), (float*)(ws + WS_LH), u, tid, wave, lane); } PHASE_END
    PHASE_BEGIN if (!NO_ML2) for (int u = bx; u < 256; u += G) mlstm::seg_pass<2>(lds, (const bf16*)(ws + WS_LQ), (const bf16*)(ws + WS_LK), (const bf16*)(ws + WS_LV), IPRE, LOGF, (float*)(ws + WS_EST), (float*)(ws + WS_NST), (float*)(ws + WS_LH), u, tid, wave, lane); if (DUP_ML) { if (!NO_ML2) for (int u = bx; u < 256; u += G) mlstm::seg_pass<2>(lds, (const bf16*)(ws + WS_LQ), (const bf16*)(ws + WS_LK), (const bf16*)(ws + WS_LV), IPRE, LOGF, (float*)(ws + WS_EST), (float*)(ws + WS_NST), (float*)(ws + WS_LH), u, tid, wave, lane); } PHASE_END
    PHASE_BEGIN mlstm5_phase(gw, ngw, lane, (const float*)(ws + WS_LH), (const bf16*)(ws + WS_LOG), I.in[22], (bf16*)(ws + WS_LA)); if (DUP_THIN) { __syncthreads(); mlstm5_phase(gw, ngw, lane, (const float*)(ws + WS_LH), (const bf16*)(ws + WS_LOG), I.in[22], (bf16*)(ws + WS_LA)); } PHASE_END
    PHASE_BEGIN { pg8::EpiResid E{X, X, MODV(2, 2), D}; run_gemm(lds, (const bf16*)(ws + WS_LA), (const bf16*)(ws + WS_LOUT), S, D, D, G, bx, E); } PHASE_END
    FFN_PHASES(2)
    CONV_PHASES(3, 1, X)
    FFN_PHASES(3)
    PHASE_BEGIN final_phase(gw, ngw, lane, X, I.in[24]); PHASE_END
#undef PHASE_BEGIN
#undef PHASE_END
}

extern "C" void kernel_launch(void* const* d_in, const int* in_sizes, int n_in, void* d_out, int out_size, void* d_ws, size_t ws_size, hipStream_t stream) {
    static int grid = 0;
    if (grid == 0) {
        if (n_in != 25 || out_size != S * D || ws_size < WS_END) { fprintf(stderr, "kernel_launch: unexpected shapes (n_in %d, out %d, ws %zu < %zu)\n", n_in, out_size, ws_size, (size_t)WS_END); grid = -1; return; }
        int dev = 0, cus = 0, per_cu = 0;
        if (hipGetDevice(&dev) != hipSuccess || hipDeviceGetAttribute(&cus, hipDeviceAttributeMultiprocessorCount, dev) != hipSuccess) { grid = -1; return; }
        if (hipFuncSetAttribute((const void*)trunk_fwd, hipFuncAttributeMaxDynamicSharedMemorySize, LDS_BYTES) != hipSuccess) { fprintf(stderr, "kernel_launch: hipFuncSetAttribute failed\n"); grid = -1; return; }
        if (hipOccupancyMaxActiveBlocksPerMultiprocessor(&per_cu, (const void*)trunk_fwd, NWAVES * 64, LDS_BYTES) != hipSuccess || per_cu < 1) { fprintf(stderr, "kernel_launch: occupancy query says %d\n", per_cu); }
        (void)hipGetLastError();
        grid = cus;
    }
    if (grid < 0) return;
    if (hipMemsetAsync((char*)d_ws + WS_CTL, 0, CTL_ZERO_BYTES, stream) != hipSuccess) return;
    Args a{};
    for (int i = 0; i < 25; ++i) a.I.in[i] = (const float*)d_in[i];
    a.out = (float*)d_out; a.ws = (unsigned char*)d_ws;
#if MK_PER_PHASE
    for (int p = 0; p < N_PHASES; ++p) { a.ph_lo = p; a.ph_hi = p + 1; hipLaunchKernelGGL(trunk_fwd, dim3(grid), dim3(NWAVES * 64), LDS_BYTES, stream, a); }
#else
    a.ph_lo = 0; a.ph_hi = N_PHASES; hipLaunchKernelGGL(trunk_fwd, dim3(grid), dim3(NWAVES * 64), LDS_BYTES, stream, a);
#endif
}
```
